# Optimizing an MI355X kernel written in HIP

```python
import jax
import jax.numpy as jnp
from jax import lax
import numpy as np

D_MODEL = 1024
BATCH = 4
SEQ = 4096
DEPTH = 4

GRID_W = 64
CTX_LEN = 256
QBLOCK = 128
ROPE_THETA = 10000.0
EPS = 1e-6

MLA_HEADS = 8
MLA_Q_RANK = 256
MLA_KV_RANK = 128
MLA_NOPE = 64
MLA_ROPE = 32
MLA_V = 64
MLA_WIDTH = MLA_HEADS * MLA_V

GQA_HEADS = 8
GQA_KV_HEADS = 2
GQA_HEAD_DIM = 64
GQA_WIDTH = GQA_HEADS * GQA_HEAD_DIM

GDN_HEADS = 4
GDN_HEAD_DIM = 128
GDN_WIDTH = GDN_HEADS * GDN_HEAD_DIM
GDN_CONV = 4
GDN_CHUNK = 64

LRU_WIDTH = 512
LRU_BLOCKS = 8
LRU_BLOCK_W = LRU_WIDTH // LRU_BLOCKS
LRU_CONV = 4
LRU_C = 8.0

DEEPNORM_ALPHA = (2 * DEPTH) ** 0.25
DEEPNORM_BETA = (8 * DEPTH) ** -0.25

N_ATT = (DEPTH + 1) // 2
N_REC = DEPTH // 2

ATT_SPLITS = (MLA_Q_RANK, MLA_KV_RANK, MLA_ROPE, MLA_WIDTH,
              GQA_WIDTH, GQA_KV_HEADS * GQA_HEAD_DIM, GQA_KV_HEADS * GQA_HEAD_DIM, GQA_WIDTH)
ATT_IN = sum(ATT_SPLITS)
ATT_MIX = MLA_WIDTH + GQA_WIDTH
REC_SPLITS = (3 * GDN_WIDTH, GDN_WIDTH, 2 * GDN_HEADS, 2 * GDN_HEADS, LRU_WIDTH, LRU_WIDTH)
REC_IN = sum(REC_SPLITS)
REC_MIX = GDN_WIDTH + LRU_WIDTH

kernel_name = 'hybrid_mla_gqa_gdn_rglru_dit_trunk'


def _split(p, sizes):
    idx = np.cumsum(sizes)[:-1].tolist()
    return jnp.split(p, idx, axis=-1)


def layer_norm(x, g, b):
    xf = x.astype(jnp.float32)
    mu = jnp.mean(xf, -1, keepdims=True)
    var = jnp.mean(jnp.square(xf - mu), -1, keepdims=True)
    return ((xf - mu) * lax.rsqrt(var + EPS) * g + b).astype(x.dtype)


def rms_norm(x, g):
    xf = x.astype(jnp.float32)
    return (xf * lax.rsqrt(jnp.mean(jnp.square(xf), -1, keepdims=True) + EPS) * g).astype(x.dtype)


def l2_norm(x):
    return x * lax.rsqrt(jnp.sum(jnp.square(x), -1, keepdims=True) + EPS)


def axial_rope_tables(row, col, dim):
    half = dim // 2
    inv = ROPE_THETA ** (-jnp.arange(0, half, 2, dtype=jnp.float32) / half)
    ang_r = row.astype(jnp.float32)[:, None] * inv
    ang_c = col.astype(jnp.float32)[:, None] * inv
    return (jnp.cos(ang_r), jnp.sin(ang_r), jnp.cos(ang_c), jnp.sin(ang_c))


def _rotate(x, cos, sin):
    x1, x2 = jnp.split(x, 2, axis=-1)
    cos = cos[None, :, None, :].astype(x.dtype)
    sin = sin[None, :, None, :].astype(x.dtype)
    return jnp.concatenate([x1 * cos - x2 * sin, x1 * sin + x2 * cos], axis=-1)


def apply_axial_rope(x, tabs):
    cr, sr, cc, sc = tabs
    xr, xc = jnp.split(x, 2, axis=-1)
    return jnp.concatenate([_rotate(xr, cr, sr), _rotate(xc, cc, sc)], axis=-1)


def block_attention(q, k, v):
    bsz, s, hk, grp, dk = q.shape
    scale = dk ** -0.5
    nb = s // QBLOCK
    qb = jnp.moveaxis(q.reshape(bsz, nb, QBLOCK, hk, grp, dk), 1, 0)

    def one_block(qblk):
        sc = jnp.einsum('bqhgd,bkhd->bhgqk', qblk, k, preferred_element_type=jnp.float32) * scale
        p = jax.nn.softmax(sc, axis=-1).astype(v.dtype)
        return jnp.einsum('bhgqk,bkhd->bqhgd', p, v)

    o = lax.map(one_block, qb)
    return jnp.moveaxis(o, 0, 1).reshape(bsz, s, hk, grp, v.shape[-1])


def _attn_project(h, w_in, q_norm_a, w_uq, kv_norm_a, w_ukv, q_norm_b, k_norm_b, rope_a, rope_b):
    bsz, t, _ = h.shape
    cq, ckv, kr, ga, qb, kb, vb, gb = _split(h @ w_in, ATT_SPLITS)
    qa = (rms_norm(cq, q_norm_a) @ w_uq).reshape(bsz, t, MLA_HEADS, MLA_NOPE + MLA_ROPE)
    kv = (rms_norm(ckv, kv_norm_a) @ w_ukv).reshape(bsz, t, MLA_HEADS, MLA_NOPE + MLA_V)
    q_nope, q_rope = qa[..., :MLA_NOPE], qa[..., MLA_NOPE:]
    k_nope, va = kv[..., :MLA_NOPE], kv[..., MLA_NOPE:]
    kr = kr[:, :, None, :]
    qb = rms_norm(qb.reshape(bsz, t, GQA_HEADS, GQA_HEAD_DIM), q_norm_b)
    kb = rms_norm(kb.reshape(bsz, t, GQA_KV_HEADS, GQA_HEAD_DIM), k_norm_b)
    vb = vb.reshape(bsz, t, GQA_KV_HEADS, GQA_HEAD_DIM)
    if rope_a is not None:
        q_rope = apply_axial_rope(q_rope, rope_a)
        kr = apply_axial_rope(kr, rope_a)
        qb = apply_axial_rope(qb, rope_b)
        kb = apply_axial_rope(kb, rope_b)
    qa = jnp.concatenate([q_nope, q_rope], -1)[:, :, :, None, :]
    ka = jnp.concatenate([k_nope, jnp.broadcast_to(kr, (bsz, t, MLA_HEADS, MLA_ROPE))], -1)
    qb = qb.reshape(bsz, t, GQA_KV_HEADS, GQA_HEADS // GQA_KV_HEADS, GQA_HEAD_DIM)
    return qa, ka, va, ga, qb, kb, vb, gb


def _attn_out(oa, ga, ob, gb, w_out):
    bsz, t = ga.shape[:2]
    mix = jnp.concatenate([oa.reshape(bsz, t, MLA_WIDTH) * jax.nn.silu(ga),
                           ob.reshape(bsz, t, GQA_WIDTH) * jax.nn.silu(gb)], -1)
    return mix @ w_out


def attention_mixer(h, h_ctx, w_in, w_out, q_norm_a, w_uq, kv_norm_a, w_ukv, q_norm_b, k_norm_b,
                    rope_a, rope_b, with_ctx):
    qa, ka, va, ga, qb, kb, vb, gb = _attn_project(h, w_in, q_norm_a, w_uq, kv_norm_a, w_ukv,
                                                   q_norm_b, k_norm_b, rope_a, rope_b)
    qa_c, ka_c, va_c, ga_c, qb_c, kb_c, vb_c, gb_c = _attn_project(h_ctx, w_in, q_norm_a, w_uq, kv_norm_a,
                                                                   w_ukv, q_norm_b, k_norm_b, None, None)
    oa = block_attention(qa, jnp.concatenate([ka_c, ka], 1), jnp.concatenate([va_c, va], 1))
    ob = block_attention(qb, jnp.concatenate([kb_c, kb], 1), jnp.concatenate([vb_c, vb], 1))
    y = _attn_out(oa, ga, ob, gb, w_out)
    y_ctx = None
    if with_ctx:
        y_ctx = _attn_out(block_attention(qa_c, ka_c, va_c), ga_c,
                          block_attention(qb_c, kb_c, vb_c), gb_c, w_out)
    return y, y_ctx


def dwconv_centered(x, w, b=None):
    ksz, ch = w.shape
    y = lax.conv_general_dilated(x, w[:, None, :].astype(x.dtype), window_strides=(1,),
                                 padding=[((ksz - 1) // 2, ksz // 2)],
                                 dimension_numbers=('NWC', 'WIO', 'NWC'), feature_group_count=ch)
    return y if b is None else y + b


def chunk_gated_delta(q, k, v, g, beta, s0):
    bsz, t, nh, dk = q.shape
    dv = v.shape[-1]
    csz = GDN_CHUNK
    nc = t // csz

    def chunks(a):
        a = a.reshape((bsz, nc, csz, nh) + a.shape[3:])
        return jnp.moveaxis(jnp.moveaxis(a, 1, 0), 2, 3)

    q = chunks(q) * (dk ** -0.5)
    k = chunks(k)
    v = chunks(v)
    beta = chunks(beta)
    g_cum = jnp.cumsum(chunks(g), axis=-1)
    idx = jnp.arange(csz)
    causal = idx[:, None] >= idx[None, :]
    strict = idx[:, None] > idx[None, :]
    decay = jnp.exp(jnp.where(causal, g_cum[..., :, None] - g_cum[..., None, :], -jnp.inf))
    kb = k * beta[..., None]
    m = jnp.where(strict, jnp.einsum('nbhid,nbhjd->nbhij', kb, k) * decay, 0.0)
    a_mat = m + jnp.eye(csz, dtype=m.dtype)
    rhs = jnp.concatenate([v * beta[..., None], kb * jnp.exp(g_cum)[..., None]], -1)
    sol = lax.linalg.triangular_solve(a_mat, rhs, left_side=True, lower=True, unit_diagonal=True)
    u, w = sol[..., :dv], sol[..., dv:]
    attn = jnp.einsum('nbhid,nbhjd->nbhij', q, k) * decay
    q_dec = q * jnp.exp(g_cum)[..., None]
    k_dec = k * jnp.exp(g_cum[..., -1:] - g_cum)[..., None]
    g_last = jnp.exp(g_cum[..., -1])

    def step(s, xs):
        qd, kd, u_n, w_n, at, gl = xs
        v_new = u_n - jnp.einsum('bhck,bhkv->bhcv', w_n, s)
        o = jnp.einsum('bhck,bhkv->bhcv', qd, s) + jnp.einsum('bhij,bhjv->bhiv', at, v_new)
        s = s * gl[..., None, None] + jnp.einsum('bhck,bhcv->bhkv', kd, v_new)
        return s, o

    s_fin, o = lax.scan(step, s0, (q_dec, k_dec, u, w, attn, g_last))
    o = jnp.transpose(o, (1, 0, 3, 2, 4)).reshape(bsz, t, nh, dv)
    return o, s_fin


def gdn_scan(q, k, v, g, beta, s0, reverse):
    if reverse:
        q, k, v, g, beta = (jnp.flip(a, 1) for a in (q, k, v, g, beta))
    o, s_fin = chunk_gated_delta(q, k, v, g, beta, s0)
    if reverse:
        o = jnp.flip(o, 1)
    return o, s_fin


def linear_scan(a, b, h0):
    def combine(l, r):
        return l[0] * r[0], r[0] * l[1] + r[1]
    a_cum, b_cum = lax.associative_scan(combine, (a, b), axis=1)
    return a_cum * h0[:, None, :] + b_cum


def lru_scan(a, b, h0, reverse):
    if reverse:
        a, b = jnp.flip(a, 1), jnp.flip(b, 1)
    h = linear_scan(a, b, h0)
    h_fin = h[:, -1]
    if reverse:
        h = jnp.flip(h, 1)
    return h, h_fin


def lru_coeffs(xl, w_gate, b_gate, lam):
    bsz, t, _ = xl.shape
    xb = xl.reshape(bsz, t, LRU_BLOCKS, LRU_BLOCK_W)
    gates = jnp.einsum('btnc,gncd->btgnd', xb, w_gate.astype(jnp.float32)).reshape(bsz, t, 2, LRU_WIDTH)
    gates = gates + b_gate.astype(jnp.float32)
    r = jax.nn.sigmoid(gates[:, :, 0])
    i = jax.nn.sigmoid(gates[:, :, 1])
    log_a = LRU_C * r * jax.nn.log_sigmoid(lam.astype(jnp.float32))
    a = jnp.exp(log_a)
    b = jnp.sqrt(-jnp.expm1(2.0 * log_a)) * (i * xl)
    return a, b


def _rec_inputs(h, w_in, gdn_conv_w, gdn_a_log, gdn_dt_bias, lru_conv_w, lru_conv_b):
    bsz, t, _ = h.shape
    qkv, z, b, a, xr, gr = _split(h @ w_in, REC_SPLITS)
    qkv = jax.nn.silu(dwconv_centered(qkv, gdn_conv_w)).astype(jnp.float32)
    q, k, v = (u.reshape(bsz, t, GDN_HEADS, GDN_HEAD_DIM) for u in jnp.split(qkv, 3, axis=-1))
    q, k = l2_norm(q), l2_norm(k)
    beta = jax.nn.sigmoid(b.astype(jnp.float32)).reshape(bsz, t, 2, GDN_HEADS)
    g = -jnp.exp(gdn_a_log.astype(jnp.float32)) * jax.nn.softplus(
        a.astype(jnp.float32).reshape(bsz, t, 2, GDN_HEADS) + gdn_dt_bias.astype(jnp.float32))
    xl = dwconv_centered(xr, lru_conv_w, lru_conv_b).astype(jnp.float32)
    return q, k, v, beta, g, z, xl, gr


def _rec_out(o, z, r, gr, gdn_norm, w_out, dtype):
    bsz, t = z.shape[:2]
    og = rms_norm(o, gdn_norm) * jax.nn.silu(z.astype(jnp.float32)).reshape(bsz, t, GDN_HEADS, GDN_HEAD_DIM)
    y_lru = r * jax.nn.silu(gr.astype(jnp.float32))
    mix = jnp.concatenate([og.reshape(bsz, t, GDN_WIDTH), y_lru], -1).astype(dtype)
    return mix @ w_out


def recurrent_mixer(h, h_ctx, w_in, w_out, gdn_conv_w, gdn_a_log, gdn_dt_bias, gdn_norm,
                    lru_conv_w, lru_conv_b, lru_gate_w, lru_gate_b, lru_lambda, with_ctx):
    q_l, k_l, v_l, beta_l, g_l, z_l, xl_l, gr_l = _rec_inputs(h, w_in, gdn_conv_w, gdn_a_log, gdn_dt_bias,
                                                              lru_conv_w, lru_conv_b)
    q_c, k_c, v_c, beta_c, g_c, z_c, xl_c, gr_c = _rec_inputs(h_ctx, w_in, gdn_conv_w, gdn_a_log, gdn_dt_bias,
                                                              lru_conv_w, lru_conv_b)
    bsz = h.shape[0]
    s0 = jnp.zeros((bsz, GDN_HEADS, GDN_HEAD_DIM, GDN_HEAD_DIM), jnp.float32)
    h0 = jnp.zeros((bsz, LRU_WIDTH), jnp.float32)
    o_l = o_c = r_l = r_c = 0.0
    for d in range(2):
        rev = d == 1
        oc, s_ctx = gdn_scan(q_c, k_c, v_c, g_c[:, :, d], beta_c[:, :, d], s0, rev)
        ol, _ = gdn_scan(q_l, k_l, v_l, g_l[:, :, d], beta_l[:, :, d], s_ctx, rev)
        a_c, b_c = lru_coeffs(xl_c, lru_gate_w[d], lru_gate_b[d], lru_lambda[d])
        hc, h_ctx_fin = lru_scan(a_c, b_c, h0, rev)
        a_l, b_l = lru_coeffs(xl_l, lru_gate_w[d], lru_gate_b[d], lru_lambda[d])
        hl, _ = lru_scan(a_l, b_l, h_ctx_fin, rev)
        o_l, o_c, r_l, r_c = o_l + ol, o_c + oc, r_l + hl, r_c + hc
    y = _rec_out(o_l, z_l, r_l, gr_l, gdn_norm, w_out, h.dtype)
    y_ctx = _rec_out(o_c, z_c, r_c, gr_c, gdn_norm, w_out, h.dtype) if with_ctx else None
    return y, y_ctx


def setup_inputs(seed: int = 0) -> dict:
    key = jax.random.key(seed)
    keys = iter(jax.random.split(key, 40))
    f32 = jnp.float32

    def nrm(shape, scale):
        return jax.random.normal(next(keys), shape, f32) * scale

    def unif(shape, lo, hi):
        return jax.random.uniform(next(keys), shape, f32, lo, hi)

    d = D_MODEL
    x = nrm((BATCH, SEQ, d), 1.0)
    c = nrm((BATCH, d), 1.0)
    ctx = nrm((BATCH, CTX_LEN, d), 1.0)
    c_ctx = nrm((d,), 1.0)
    mod_w = nrm((DEPTH, d, 3 * d), d ** -0.5)
    mod_b = nrm((DEPTH, 3 * d), 0.02)
    ln_g = 1.0 + nrm((DEPTH, d), 0.02)
    ln_b = nrm((DEPTH, d), 0.02)
    att_w_in = nrm((N_ATT, d, ATT_IN), d ** -0.5)
    att_w_out = nrm((N_ATT, ATT_MIX, d), ATT_MIX ** -0.5 * DEEPNORM_BETA)
    mla_q_norm = 1.0 + nrm((N_ATT, MLA_Q_RANK), 0.02)
    mla_w_uq = nrm((N_ATT, MLA_Q_RANK, MLA_HEADS * (MLA_NOPE + MLA_ROPE)), MLA_Q_RANK ** -0.5)
    mla_kv_norm = 1.0 + nrm((N_ATT, MLA_KV_RANK), 0.02)
    mla_w_ukv = nrm((N_ATT, MLA_KV_RANK, MLA_HEADS * (MLA_NOPE + MLA_V)), MLA_KV_RANK ** -0.5)
    gqa_q_norm = 1.0 + nrm((N_ATT, GQA_HEAD_DIM), 0.02)
    gqa_k_norm = 1.0 + nrm((N_ATT, GQA_HEAD_DIM), 0.02)
    rec_w_in = nrm((N_REC, d, REC_IN), d ** -0.5)
    rec_w_out = nrm((N_REC, REC_MIX, d), REC_MIX ** -0.5 * DEEPNORM_BETA)
    gdn_conv_w = nrm((N_REC, GDN_CONV, 3 * GDN_WIDTH), GDN_CONV ** -0.5)
    gdn_a_log = jnp.log(unif((N_REC, 2, GDN_HEADS), 1.0, 16.0))
    dt = jnp.exp(unif((N_REC, 2, GDN_HEADS), float(np.log(1e-3)), float(np.log(1e-1))))
    gdn_dt_bias = dt + jnp.log(-jnp.expm1(-dt))
    gdn_norm = 1.0 + nrm((N_REC, GDN_HEAD_DIM), 0.02)
    lru_conv_w = nrm((N_REC, LRU_CONV, LRU_WIDTH), LRU_CONV ** -0.5)
    lru_conv_b = nrm((N_REC, LRU_WIDTH), 0.02)
    lru_gate_w = nrm((N_REC, 2, 2, LRU_BLOCKS, LRU_BLOCK_W, LRU_BLOCK_W), LRU_BLOCK_W ** -0.5)
    lru_gate_b = nrm((N_REC, 2, 2, LRU_WIDTH), 0.02)
    a_c = unif((N_REC, 2, LRU_WIDTH), 0.9, 0.999) ** (1.0 / LRU_C)
    lru_lambda = jnp.log(a_c) - jnp.log1p(-a_c)
    return {'x': x, 'c': c, 'ctx': ctx, 'c_ctx': c_ctx, 'mod_w': mod_w, 'mod_b': mod_b,
            'ln_g': ln_g, 'ln_b': ln_b, 'att_w_in': att_w_in, 'att_w_out': att_w_out,
            'mla_q_norm': mla_q_norm, 'mla_w_uq': mla_w_uq, 'mla_kv_norm': mla_kv_norm,
            'mla_w_ukv': mla_w_ukv, 'gqa_q_norm': gqa_q_norm, 'gqa_k_norm': gqa_k_norm,
            'rec_w_in': rec_w_in, 'rec_w_out': rec_w_out, 'gdn_conv_w': gdn_conv_w,
            'gdn_a_log': gdn_a_log, 'gdn_dt_bias': gdn_dt_bias, 'gdn_norm': gdn_norm,
            'lru_conv_w': lru_conv_w, 'lru_conv_b': lru_conv_b, 'lru_gate_w': lru_gate_w,
            'lru_gate_b': lru_gate_b, 'lru_lambda': lru_lambda}


def reference(x, c, ctx, c_ctx, mod_w, mod_b, ln_g, ln_b, att_w_in, att_w_out, mla_q_norm, mla_w_uq,
              mla_kv_norm, mla_w_ukv, gqa_q_norm, gqa_k_norm, rec_w_in, rec_w_out, gdn_conv_w,
              gdn_a_log, gdn_dt_bias, gdn_norm, lru_conv_w, lru_conv_b, lru_gate_w, lru_gate_b, lru_lambda):
    n = x.shape[1]
    rows = n // GRID_W
    row = jnp.repeat(jnp.arange(rows), GRID_W)
    col = jnp.tile(jnp.arange(GRID_W), rows)
    rope_mla = axial_rope_tables(row, col, MLA_ROPE)
    rope_gqa = axial_rope_tables(row, col, GQA_HEAD_DIM)
    sc = jax.nn.silu(c)
    sc_ctx = jax.nn.silu(c_ctx)
    for layer in range(DEPTH):
        last = layer == DEPTH - 1
        shift, scale, gate = jnp.split(sc @ mod_w[layer] + mod_b[layer], 3, axis=-1)
        shift_c, scale_c, gate_c = jnp.split(sc_ctx @ mod_w[layer] + mod_b[layer], 3, axis=-1)
        h = x * (1.0 + scale[:, None]) + shift[:, None]
        h_ctx = ctx * (1.0 + scale_c) + shift_c
        li = layer // 2
        if layer % 2 == 0:
            y, y_ctx = attention_mixer(h, h_ctx, att_w_in[li], att_w_out[li], mla_q_norm[li], mla_w_uq[li],
                                       mla_kv_norm[li], mla_w_ukv[li], gqa_q_norm[li], gqa_k_norm[li],
                                       rope_mla, rope_gqa, not last)
        else:
            y, y_ctx = recurrent_mixer(h, h_ctx, rec_w_in[li], rec_w_out[li], gdn_conv_w[li], gdn_a_log[li],
                                       gdn_dt_bias[li], gdn_norm[li], lru_conv_w[li], lru_conv_b[li],
                                       lru_gate_w[li], lru_gate_b[li], lru_lambda[li], not last)
        x = layer_norm(DEEPNORM_ALPHA * x + gate[:, None] * y, ln_g[layer], ln_b[layer])
        if not last:
            ctx = layer_norm(DEEPNORM_ALPHA * ctx + gate_c * y_ctx, ln_g[layer], ln_b[layer])
    return x
```

```cpp
#ifndef HOST_TEST
#include <hip/hip_runtime.h>
#include <hip/hip_cooperative_groups.h>
#include <cstdio>
namespace cg = cooperative_groups;
#define HD __host__ __device__ __forceinline__
#else
#include <cmath>
#include <cstdio>
#include <cstdlib>
#include <cstring>
struct float4 { float x, y, z, w; };
#define HD inline
#endif
#include <math.h>
#include <stddef.h>
#include <string.h>

#ifndef CFG_BATCH
#define CFG_BATCH 4
#define CFG_SEQ 4096
#define CFG_CTX 256
#endif

constexpr int D = 1024, NB = CFG_BATCH, SEQ = CFG_SEQ, CTX = CFG_CTX;
constexpr int NT = SEQ + CTX;
constexpr int NTOK = NT;
constexpr int ATT_IN = 2208, REC_IN = 3088, PROJ_LD = 3088;
constexpr int MODROWS = NB + 1;
constexpr float EPS = 1e-6f;
constexpr float DN_ALPHA = 1.681792830507429f;
constexpr int A_CQ = 0, A_CKV = 256, A_KR = 384, A_GA = 416, A_QB = 928, A_KB = 1440, A_VB = 1568, A_GB = 1696;
constexpr int R_QKV = 0, R_Z = 1536, R_B = 2048, R_A = 2056, R_XR = 2064, R_GR = 2576;

struct Params {
  const float *x, *c, *ctx, *c_ctx, *mod_w, *mod_b, *ln_g, *ln_b, *att_w_in, *att_w_out, *mla_q_norm, *mla_w_uq,
      *mla_kv_norm, *mla_w_ukv, *gqa_q_norm, *gqa_k_norm, *rec_w_in, *rec_w_out, *gdn_conv_w, *gdn_a_log,
      *gdn_dt_bias, *gdn_norm, *lru_conv_w, *lru_conv_b, *lru_gate_w, *lru_gate_b, *lru_lambda;
  float* out;
  float *modv, *Xctx, *proj, *rinvq, *rinvkv, *qa_raw, *kv_raw, *QA, *KA, *QB, *KB, *mix, *y;
  float *gq, *gk, *gv, *gbeta, *gg, *xl, *la, *lb, *odir, *rdir;
  unsigned short *H, *mixh, *WtIn, *WtOut;
  unsigned short *CQ, *CKV, *QG, *KG, *VTG, *KRb, *GAB, *QN, *QR, *KN, *VTA, *Wuq, *Wukv;
  float *sqq, *sqkv, *ropeG, *ropeM;
  unsigned short *PQKV, *PZG, *PXR, *GQ, *GK, *GV, *TG, *ATTG, *ODIR, *WG;
  float *PBA, *GCB, *LCAR, *LHIN;
  unsigned* bar;
  char* ws;
};

HD unsigned short f2bf(float f) {
  unsigned u; memcpy(&u, &f, 4);
  u += 0x7fffu + ((u >> 16) & 1u);
  return (unsigned short)(u >> 16);
}
HD float sigmoidf_(float x) { return 1.0f / (1.0f + expf(-x)); }
HD float siluf_(float x) { return x / (1.0f + expf(-x)); }
HD float softplusf_(float x) { return x > 20.0f ? x : log1pf(expf(x)); }
HD float rsq_(float x) { return 1.0f / sqrtf(x); }
HD int tok_modrow(int b, int tok) { return tok < SEQ ? b : NB; }
HD float* xrow(const Params& p, int b, int tok) {
  return tok < SEQ ? p.out + ((size_t)b * SEQ + tok) * D : p.Xctx + ((size_t)b * CTX + (tok - SEQ)) * D;
}

HD void mod_item(const Params& p, long i) {
  int j = (int)(i % 3072);
  int r = (int)((i / 3072) % MODROWS);
  int l = (int)(i / (3072 * MODROWS));
  const float* cv = r < NB ? p.c + (size_t)r * D : p.c_ctx;
  const float* w = p.mod_w + (size_t)l * D * 3072 + j;
  float acc = 0.f;
  for (int k = 0; k < D; ++k) acc += siluf_(cv[k]) * w[(size_t)k * 3072];
  p.modv[i] = acc + p.mod_b[l * 3072 + j];
}

HD void copy_item(const Params& p, long i) {
  if (i < (long)NB * SEQ * D) p.out[i] = p.x[i];
  else p.Xctx[i - (long)NB * SEQ * D] = p.ctx[i - (long)NB * SEQ * D];
}

struct Gemm {
  const float* A; int lda; const float* W; int N; int K; float* C; int ldc;
  const float* rowscale; const float* kvec; const float* mod;
  const float* xlat; const float* xctx; int b;
};
HD void gemm_item(const Gemm& g, long item) {
  const int ncg = g.N / 4;
  const int rg = (int)(item / ncg), cgp = (int)(item % ncg);
  const int r0 = rg * 8, c0 = cgp * 4;
  float acc[8][4];
#pragma unroll
  for (int r = 0; r < 8; ++r)
#pragma unroll
    for (int c = 0; c < 4; ++c) acc[r][c] = 0.f;
  const bool hasmod = g.mod != nullptr;
  const bool haskv = g.kvec != nullptr;
  const float* modrow = hasmod ? g.mod + (size_t)tok_modrow(g.b, r0) * 3072 : g.W;
  const float* kvec = haskv ? g.kvec : g.W;
  const float* abase;
  size_t astride;
  if (g.xlat) {
    abase = r0 < SEQ ? g.xlat + ((size_t)g.b * SEQ + r0) * D : g.xctx + ((size_t)g.b * CTX + (r0 - SEQ)) * D;
    astride = D;
  } else {
    abase = g.A + (size_t)r0 * g.lda;
    astride = g.lda;
  }
  float rs[8];
#pragma unroll
  for (int r = 0; r < 8; ++r) rs[r] = g.rowscale ? g.rowscale[r0 + r] : 1.0f;
  for (int k = 0; k < g.K; k += 4) {
    float4 w[4];
#pragma unroll
    for (int kk = 0; kk < 4; ++kk) w[kk] = *(const float4*)(g.W + (size_t)(k + kk) * g.N + c0);
    float ks[4], kb[4];
#pragma unroll
    for (int kk = 0; kk < 4; ++kk) {
      ks[kk] = hasmod ? 1.0f + modrow[1024 + k + kk] : (haskv ? kvec[k + kk] : 1.0f);
      kb[kk] = hasmod ? modrow[k + kk] : 0.f;
    }
#pragma unroll
    for (int r = 0; r < 8; ++r) {
      float4 a = *(const float4*)(abase + (size_t)r * astride + k);
      float a0 = a.x * rs[r] * ks[0] + kb[0];
      float a1 = a.y * rs[r] * ks[1] + kb[1];
      float a2 = a.z * rs[r] * ks[2] + kb[2];
      float a3 = a.w * rs[r] * ks[3] + kb[3];
      acc[r][0] += a0 * w[0].x + a1 * w[1].x + a2 * w[2].x + a3 * w[3].x;
      acc[r][1] += a0 * w[0].y + a1 * w[1].y + a2 * w[2].y + a3 * w[3].y;
      acc[r][2] += a0 * w[0].z + a1 * w[1].z + a2 * w[2].z + a3 * w[3].z;
      acc[r][3] += a0 * w[0].w + a1 * w[1].w + a2 * w[2].w + a3 * w[3].w;
    }
  }
#pragma unroll
  for (int r = 0; r < 8; ++r) {
    float4 o; o.x = acc[r][0]; o.y = acc[r][1]; o.z = acc[r][2]; o.w = acc[r][3];
    *(float4*)(g.C + (size_t)(r0 + r) * g.ldc + c0) = o;
  }
}

HD void attnorm_item(const Params& p, long tok) {
  const float* pr = p.proj + (size_t)tok * PROJ_LD;
  float s = 0.f;
  for (int k = 0; k < 256; ++k) s += pr[A_CQ + k] * pr[A_CQ + k];
  p.rinvq[tok] = rsq_(s / 256.0f + EPS);
  s = 0.f;
  for (int k = 0; k < 128; ++k) s += pr[A_CKV + k] * pr[A_CKV + k];
  p.rinvkv[tok] = rsq_(s / 128.0f + EPS);
}

template <int NH>
HD void rope_apply(const float* in, float* out, int row, int col) {
  constexpr int Q = NH / 2;
#pragma unroll
  for (int i = 0; i < Q; ++i) {
    float inv = powf(10000.0f, -(float)(2 * i) / (float)NH);
    float ar = (float)row * inv, ac = (float)col * inv;
    float cr = cosf(ar), sr = sinf(ar), cc = cosf(ac), sc = sinf(ac);
    float x1 = in[i], x2 = in[Q + i];
    out[i] = x1 * cr - x2 * sr;
    out[Q + i] = x1 * sr + x2 * cr;
    float y1 = in[NH + i], y2 = in[NH + Q + i];
    out[NH + i] = y1 * cc - y2 * sc;
    out[NH + Q + i] = y1 * sc + y2 * cc;
  }
}

HD void assemble_item(const Params& p, int li, long i) {
  const int h = (int)(i & 7);
  const int tok = (int)(i >> 3);
  const bool lat = tok < SEQ;
  const int t = lat ? tok : 0;
  const int row = t / 64, col = t % 64;
  const float* pr = p.proj + (size_t)tok * PROJ_LD;
  {
    const float* qr = p.qa_raw + (size_t)tok * 768 + h * 96;
    float* qo = p.QA + ((size_t)tok * 8 + h) * 96;
    for (int d = 0; d < 64; ++d) qo[d] = qr[d];
    if (lat) rope_apply<16>(qr + 64, qo + 64, row, col);
    else for (int d = 64; d < 96; ++d) qo[d] = qr[d];
  }
  {
    const float* kr = p.kv_raw + (size_t)tok * 1024 + h * 128;
    float* ko = p.KA + ((size_t)tok * 8 + h) * 96;
    for (int d = 0; d < 64; ++d) ko[d] = kr[d];
    if (lat) rope_apply<16>(pr + A_KR, ko + 64, row, col);
    else for (int d = 0; d < 32; ++d) ko[64 + d] = pr[A_KR + d];
  }
  {
    const float* q = pr + A_QB + h * 64;
    const float* nw = p.gqa_q_norm + li * 64;
    float* qo = p.QB + ((size_t)tok * 8 + h) * 64;
    float s = 0.f;
    for (int d = 0; d < 64; ++d) s += q[d] * q[d];
    float rinv = rsq_(s / 64.0f + EPS);
    for (int d = 0; d < 64; ++d) qo[d] = q[d] * rinv * nw[d];
    if (lat) rope_apply<32>(qo, qo, row, col);
  }
  if (h < 2) {
    const float* q = pr + A_KB + h * 64;
    const float* nw = p.gqa_k_norm + li * 64;
    float* qo = p.KB + ((size_t)tok * 2 + h) * 64;
    float s = 0.f;
    for (int d = 0; d < 64; ++d) s += q[d] * q[d];
    float rinv = rsq_(s / 64.0f + EPS);
    for (int d = 0; d < 64; ++d) qo[d] = q[d] * rinv * nw[d];
    if (lat) rope_apply<32>(qo, qo, row, col);
  }
}

template <int DQK>
HD void attn_item(const Params& p, int b, int mixer, int h, int tok) {
  const float* qp = mixer == 0 ? p.QA + ((size_t)tok * 8 + h) * 96 : p.QB + ((size_t)tok * 8 + h) * 64;
  float q[DQK];
  const float scale = mixer == 0 ? 0.10206207261596575f : 0.125f;
#pragma unroll
  for (int d = 0; d < DQK; ++d) q[d] = qp[d] * scale;
  float o[64];
#pragma unroll
  for (int d = 0; d < 64; ++d) o[d] = 0.f;
  float mx = -1e30f, l = 0.f;
  const bool lat = tok < SEQ;
  for (int seg = 0; seg < (lat ? 2 : 1); ++seg) {
    const int k0 = seg == 0 ? SEQ : 0;
    const int kn = seg == 0 ? CTX : SEQ;
    for (int kk = 0; kk < kn; ++kk) {
      const int kt = k0 + kk;
      const float* kp = mixer == 0 ? p.KA + ((size_t)kt * 8 + h) * 96 : p.KB + ((size_t)kt * 2 + (h >> 2)) * 64;
      const float* vp = mixer == 0 ? p.kv_raw + (size_t)kt * 1024 + h * 128 + 64
                                   : p.proj + (size_t)kt * PROJ_LD + A_VB + (h >> 2) * 64;
      float s = 0.f;
#pragma unroll
      for (int d = 0; d < DQK; d += 4) {
        float4 kv = *(const float4*)(kp + d);
        s += q[d] * kv.x + q[d + 1] * kv.y + q[d + 2] * kv.z + q[d + 3] * kv.w;
      }
      float mn = fmaxf(mx, s);
      float alpha = expf(mx - mn);
      float pe = expf(s - mn);
      l = l * alpha + pe;
      mx = mn;
#pragma unroll
      for (int d = 0; d < 64; d += 4) {
        float4 vv = *(const float4*)(vp + d);
        o[d] = o[d] * alpha + pe * vv.x;
        o[d + 1] = o[d + 1] * alpha + pe * vv.y;
        o[d + 2] = o[d + 2] * alpha + pe * vv.z;
        o[d + 3] = o[d + 3] * alpha + pe * vv.w;
      }
    }
  }
  const float invl = 1.0f / l;
  const float* gate = p.proj + (size_t)tok * PROJ_LD + (mixer == 0 ? A_GA : A_GB) + h * 64;
  float* mo = p.mix + (size_t)tok * 1024 + mixer * 512 + h * 64;
  unsigned short* mh = p.mixh + ((size_t)b * NT + tok) * 1024 + mixer * 512 + h * 64;
#pragma unroll
  for (int d = 0; d < 64; ++d) {
    float v = o[d] * invl * siluf_(gate[d]);
#ifdef HOST_TEST
    mo[d] = v;
#endif
    mh[d] = f2bf(v);
  }
  (void)mo;
}

HD void ln_item(const Params& p, int layer, int b, long tok) {
  const float* modrow = p.modv + ((size_t)layer * MODROWS + tok_modrow(b, (int)tok)) * 3072 + 2048;
  float* xr = xrow(p, b, (int)tok);
  const float* yr = p.y + (size_t)tok * D;
  float s = 0.f;
  for (int j = 0; j < D; ++j) s += DN_ALPHA * xr[j] + modrow[j] * yr[j];
  const float mu = s / D;
  float v = 0.f;
  for (int j = 0; j < D; ++j) { float z = DN_ALPHA * xr[j] + modrow[j] * yr[j] - mu; v += z * z; }
  const float rstd = rsq_(v / D + EPS);
  const float* g = p.ln_g + layer * D;
  const float* bb = p.ln_b + layer * D;
  float* dst = xr;
  const float* modn = layer < 3 ? p.modv + ((size_t)(layer + 1) * MODROWS + tok_modrow(b, (int)tok)) * 3072 : nullptr;
  unsigned short* hrow = p.H + ((size_t)b * NT + tok) * D;
  for (int j = 0; j < D; ++j) {
    float z = DN_ALPHA * xr[j] + modrow[j] * yr[j];
    float xn = (z - mu) * rstd * g[j] + bb[j];
    dst[j] = xn;
    if (modn) hrow[j] = f2bf(xn * (1.0f + modn[1024 + j]) + modn[j]);
  }
}

HD void h0_item(const Params& p, long i) {
  const int j = (int)(i % D);
  const int tok = (int)((i / D) % NT);
  const int b = (int)(i / ((long)D * NT));
  const float* modn = p.modv + ((size_t)tok_modrow(b, tok)) * 3072;
  const float xv = tok < SEQ ? p.x[((size_t)b * SEQ + tok) * D + j] : p.ctx[((size_t)b * CTX + (tok - SEQ)) * D + j];
  p.H[i] = f2bf(xv * (1.0f + modn[1024 + j]) + modn[j]);
}

constexpr int ATT_NPAD = 2304, REC_NPAD = 3200;
constexpr int WT_IN_ROWS = 2 * ATT_NPAD + 2 * REC_NPAD;
HD size_t wtin_row0(int layer) { return (size_t)(layer >> 1) * (ATT_NPAD + REC_NPAD) + ((layer & 1) ? ATT_NPAD : 0); }
HD void wconv_item(const float* src, int nsrc, unsigned short* dst, long i) {
  const int kg = (int)(i & 63);
  const int col = (int)(i >> 6);
  unsigned* d32 = (unsigned*)(dst + (size_t)col * D + kg * 16);
#pragma unroll
  for (int t = 0; t < 8; ++t) {
    unsigned lo = 0, hi = 0;
    if (col < nsrc) {
      lo = f2bf(src[(size_t)(kg * 16 + 2 * t) * nsrc + col]);
      hi = f2bf(src[(size_t)(kg * 16 + 2 * t + 1) * nsrc + col]);
    }
    d32[t] = lo | (hi << 16);
  }
}

HD float conv4(const Params& p, int tok, int colidx, const float* w, int wstride, int c) {
  const bool lat = tok < SEQ;
  const int T = lat ? SEQ : CTX;
  const int t = lat ? tok : tok - SEQ;
  float acc = 0.f;
#pragma unroll
  for (int j = 0; j < 4; ++j) {
    int tt = t - 1 + j;
    if (tt >= 0 && tt < T) acc += w[j * wstride + c] * p.proj[(size_t)(tok - 1 + j) * PROJ_LD + colidx];
  }
  return acc;
}

HD void recpre_item(const Params& p, int li, long i) {
  const int slot = (int)(i % 17);
  const int tok = (int)(i / 17);
  if (slot < 12) {
    const int part = slot >> 2, hh = slot & 3;
    const int cb = part * 512 + hh * 128;
    const float* w = p.gdn_conv_w + (size_t)li * 4 * 1536;
    float ss = 0.f;
    if (part < 2) {
      for (int c = 0; c < 128; ++c) { float v = siluf_(conv4(p, tok, R_QKV + cb + c, w, 1536, cb + c)); ss += v * v; }
    }
    float sc = part < 2 ? rsq_(ss + EPS) : 1.0f;
    if (part == 0) sc *= 0.08838834764831845f;
    float* dst = (part == 0 ? p.gq + 0 : part == 1 ? p.gk + 0 : p.gv + 0) + ((size_t)tok * 4 + hh) * 128;
    for (int c = 0; c < 128; ++c) dst[c] = siluf_(conv4(p, tok, R_QKV + cb + c, w, 1536, cb + c)) * sc;
  } else if (slot == 12) {
    const float* pr = p.proj + (size_t)tok * PROJ_LD;
    for (int j = 0; j < 8; ++j) {
      p.gbeta[(size_t)tok * 8 + j] = sigmoidf_(pr[R_B + j]);
      p.gg[(size_t)tok * 8 + j] = -expf(p.gdn_a_log[li * 8 + j]) * softplusf_(pr[R_A + j] + p.gdn_dt_bias[li * 8 + j]);
    }
  } else {
    const int cb = (slot - 13) * 128;
    const float* w = p.lru_conv_w + (size_t)li * 4 * 512;
    for (int c = 0; c < 128; ++c)
      p.xl[(size_t)tok * 512 + cb + c] = conv4(p, tok, R_XR + cb + c, w, 512, cb + c) + p.lru_conv_b[li * 512 + cb + c];
  }
}

HD void lrucoef_item(const Params& p, int li, long i) {
  const int ch = (int)(i & 511);
  const int tok = (int)((i >> 9) % NTOK);
  const int d = (int)((i >> 9) / NTOK);
  const int n = ch >> 6, dd = ch & 63;
  const float* xb = p.xl + (size_t)tok * 512 + n * 64;
  const float* w0 = p.lru_gate_w + ((((size_t)li * 2 + d) * 2 + 0) * 8 + n) * 4096 + dd;
  const float* w1 = p.lru_gate_w + ((((size_t)li * 2 + d) * 2 + 1) * 8 + n) * 4096 + dd;
  float g0 = 0.f, g1 = 0.f;
  for (int c = 0; c < 64; ++c) { g0 += xb[c] * w0[c * 64]; g1 += xb[c] * w1[c * 64]; }
  g0 += p.lru_gate_b[(((size_t)li * 2 + d) * 2 + 0) * 512 + ch];
  g1 += p.lru_gate_b[(((size_t)li * 2 + d) * 2 + 1) * 512 + ch];
  const float r = sigmoidf_(g0), ig = sigmoidf_(g1);
  const float lam = p.lru_lambda[((size_t)li * 2 + d) * 512 + ch];
  const float log_a = 8.0f * r * (-softplusf_(-lam));
  p.la[((size_t)d * NTOK + tok) * 512 + ch] = expf(log_a);
  p.lb[((size_t)d * NTOK + tok) * 512 + ch] = sqrtf(-expm1f(2.0f * log_a)) * (ig * p.xl[(size_t)tok * 512 + ch]);
}

HD void gdnseq_item(const Params& p, long i) {
  const int col = (int)(i & 127);
  const int hh = (int)((i >> 7) & 3);
  const int d = (int)((i >> 9) & 1);
  float S[128];
#pragma unroll
  for (int k = 0; k < 128; ++k) S[k] = 0.f;
  for (int seg = 0; seg < 2; ++seg) {
    const int base = seg == 0 ? SEQ : 0;
    const int T = seg == 0 ? CTX : SEQ;
    for (int step = 0; step < T; ++step) {
      const int tok = base + (d == 0 ? step : T - 1 - step);
      const float a = expf(p.gg[(size_t)tok * 8 + d * 4 + hh]);
      const float beta = p.gbeta[(size_t)tok * 8 + d * 4 + hh];
      const float* kp = p.gk + ((size_t)tok * 4 + hh) * 128;
      const float* qp = p.gq + ((size_t)tok * 4 + hh) * 128;
      const float v = p.gv[((size_t)tok * 4 + hh) * 128 + col];
      float dot = 0.f;
#pragma unroll
      for (int k = 0; k < 128; k += 4) {
        float4 kv = *(const float4*)(kp + k);
        S[k] *= a; S[k + 1] *= a; S[k + 2] *= a; S[k + 3] *= a;
        dot += kv.x * S[k] + kv.y * S[k + 1] + kv.z * S[k + 2] + kv.w * S[k + 3];
      }
      const float vn = beta * (v - dot);
      float o = 0.f;
#pragma unroll
      for (int k = 0; k < 128; k += 4) {
        float4 kv = *(const float4*)(kp + k);
        float4 qv = *(const float4*)(qp + k);
        S[k] += kv.x * vn; S[k + 1] += kv.y * vn; S[k + 2] += kv.z * vn; S[k + 3] += kv.w * vn;
        o += qv.x * S[k] + qv.y * S[k + 1] + qv.z * S[k + 2] + qv.w * S[k + 3];
      }
      p.odir[(((size_t)d * NTOK + tok) * 4 + hh) * 128 + col] = o;
    }
  }
}

HD void lruseq_item(const Params& p, long i) {
  const int ch = (int)(i & 511);
  const int d = (int)((i >> 9) & 1);
  float h = 0.f;
  for (int seg = 0; seg < 2; ++seg) {
    const int base = seg == 0 ? SEQ : 0;
    const int T = seg == 0 ? CTX : SEQ;
    for (int step = 0; step < T; ++step) {
      const int tok = base + (d == 0 ? step : T - 1 - step);
      const size_t idx = ((size_t)d * NTOK + tok) * 512 + ch;
      h = p.la[idx] * h + p.lb[idx];
      p.rdir[idx] = h;
    }
  }
}

HD void recout_item(const Params& p, int li, int b, long i) {
  const int slot = (int)(i & 7);
  const int tok = (int)(i >> 3);
  const float* pr = p.proj + (size_t)tok * PROJ_LD;
  float* mo = p.mix + (size_t)tok * 1024;
  if (slot < 4) {
    const float* o0 = p.odir + (((size_t)0 * NTOK + tok) * 4 + slot) * 128;
    const float* o1 = p.odir + (((size_t)1 * NTOK + tok) * 4 + slot) * 128;
    float ss = 0.f;
    for (int c = 0; c < 128; ++c) { float o = o0[c] + o1[c]; ss += o * o; }
    const float rinv = rsq_(ss / 128.0f + EPS);
    for (int c = 0; c < 128; ++c) {
      float v = (o0[c] + o1[c]) * rinv * p.gdn_norm[li * 128 + c] * siluf_(pr[R_Z + slot * 128 + c]);
#ifdef HOST_TEST
      mo[slot * 128 + c] = v;
#endif
      p.mixh[((size_t)b * NT + tok) * 1024 + slot * 128 + c] = f2bf(v);
    }
  } else {
    const int cb = (slot - 4) * 128;
    for (int c = 0; c < 128; ++c) {
      const int ch = cb + c;
      float r = p.rdir[((size_t)0 * NTOK + tok) * 512 + ch] + p.rdir[((size_t)1 * NTOK + tok) * 512 + ch];
      float v = r * siluf_(pr[R_GR + ch]);
#ifdef HOST_TEST
      mo[512 + ch] = v;
#endif
      p.mixh[((size_t)b * NT + tok) * 1024 + 512 + ch] = f2bf(v);
    }
  }
}

#ifdef HOST_TEST
enum { K_GEMM = 0, K_ATTNORM, K_ASSEMBLE, K_ATTN, K_LN, K_RECPRE, K_LRUCOEF, K_GDNSEQ, K_LRUSEQ, K_RECOUT };

HD void make_op(const Params& p, int layer, int b, int ph, int& kind, long& n, Gemm& g) {
  const int li = layer >> 1;
  const bool last = layer == 3;
  const bool att = (layer & 1) == 0;
  const float* modl = p.modv + (size_t)layer * MODROWS * 3072;
  g.A = p.mix; g.lda = D; g.W = p.att_w_out; g.N = D; g.K = D; g.C = p.y; g.ldc = D;
  g.rowscale = nullptr; g.kvec = nullptr; g.mod = nullptr; g.xlat = nullptr; g.xctx = nullptr; g.b = b;
  kind = K_GEMM; n = 0;
  if (ph == 0) {
    g.A = p.out; g.xlat = p.out; g.xctx = p.Xctx; g.mod = modl; g.C = p.proj; g.ldc = PROJ_LD;
    g.W = att ? p.att_w_in + (size_t)li * D * ATT_IN : p.rec_w_in + (size_t)li * D * REC_IN;
    g.N = att ? ATT_IN : REC_IN;
    n = (long)(NT / 8) * (g.N / 4);
  } else if (ph == 6) {
    g.W = att ? p.att_w_out + (size_t)li * D * D : p.rec_w_out + (size_t)li * D * D;
    n = (long)(NT / 8) * (D / 4);
  } else if (ph == 7) {
    kind = K_LN; n = last ? SEQ : NT;
  } else if (att) {
    if (ph == 1) { kind = K_ATTNORM; n = NT; }
    else if (ph == 2) {
      g.A = p.proj + A_CQ; g.lda = PROJ_LD; g.W = p.mla_w_uq + (size_t)li * 256 * 768; g.N = 768; g.K = 256;
      g.C = p.qa_raw; g.ldc = 768; g.rowscale = p.rinvq; g.kvec = p.mla_q_norm + li * 256;
      n = (long)(NT / 8) * (768 / 4);
    } else if (ph == 3) {
      g.A = p.proj + A_CKV; g.lda = PROJ_LD; g.W = p.mla_w_ukv + (size_t)li * 128 * 1024; g.N = 1024; g.K = 128;
      g.C = p.kv_raw; g.ldc = 1024; g.rowscale = p.rinvkv; g.kvec = p.mla_kv_norm + li * 128;
      n = (long)(NT / 8) * (1024 / 4);
    } else if (ph == 4) { kind = K_ASSEMBLE; n = (long)NT * 8; }
    else { kind = K_ATTN; n = (long)NT * 16; }
  } else {
    if (ph == 1) { kind = K_RECPRE; n = (long)NT * 17; }
    else if (ph == 2) { kind = K_LRUCOEF; n = (long)2 * NT * 512; }
    else if (ph == 3) { kind = K_GDNSEQ; n = 2 * 4 * 128; }
    else if (ph == 4) { kind = K_LRUSEQ; n = 2 * 512; }
    else { kind = K_RECOUT; n = (long)NT * 8; }
  }
}

#ifdef HOST_TEST
#define FOR_ITEMS(n) _Pragma("omp parallel for schedule(dynamic, 16)") for (long i = 0; i < (long)(n); ++i)
#define GRID_SYNC()
void forward_host(const Params& p)
#else
#define FOR_ITEMS(n) for (long i = gtid; i < (long)(n); i += gstride)
#define GRID_SYNC() grid.sync()
__global__ void __launch_bounds__(256) megakernel(Params p)
#endif
{
#ifndef HOST_TEST
  cg::grid_group grid = cg::this_grid();
  const long gtid = (long)blockIdx.x * blockDim.x + threadIdx.x;
  const long gstride = (long)gridDim.x * blockDim.x;
#endif
  FOR_ITEMS((long)4 * MODROWS * 3072) { mod_item(p, i); }
  FOR_ITEMS((long)NB * NT * D) { copy_item(p, i); }
  GRID_SYNC();
  for (int step = 0; step < 4 * NB * 8; ++step) {
    const int layer = step / (NB * 8);
    const int b = (step / 8) % NB;
    const int ph = step & 7;
    const int li = layer >> 1;
    int kind; long n; Gemm g;
    make_op(p, layer, b, ph, kind, n, g);
    FOR_ITEMS(n) {
      switch (kind) {
        case K_GEMM: gemm_item(g, i); break;
        case K_ATTNORM: attnorm_item(p, i); break;
        case K_ASSEMBLE: assemble_item(p, li, i); break;
        case K_ATTN: {
          const int tok = (int)(i % NT);
          const int mh = (int)(i / NT);
          if (mh < 8) attn_item<96>(p, b, 0, mh, tok);
          else attn_item<64>(p, b, 1, mh - 8, tok);
        } break;
        case K_LN: ln_item(p, layer, b, i); break;
        case K_RECPRE: recpre_item(p, li, i); break;
        case K_LRUCOEF: lrucoef_item(p, li, i); break;
        case K_GDNSEQ: gdnseq_item(p, i); break;
        case K_LRUSEQ: lruseq_item(p, i); break;
        default: recout_item(p, li, b, i); break;
      }
    }
    GRID_SYNC();
  }
}

static size_t carve(Params& p, float* ws) {
  size_t off = 0;
  auto take = [&](size_t n) { float* r = ws + off; off += (n + 63) & ~(size_t)63; return r; };
  p.modv = take((size_t)4 * MODROWS * 3072);
  p.Xctx = take((size_t)NB * CTX * D);
  p.H = (unsigned short*)take((size_t)NB * NT * D / 2);
  p.mixh = (unsigned short*)take((size_t)NB * NT * D / 2);
  p.proj = take((size_t)NT * PROJ_LD);
  p.mix = take((size_t)NT * 1024);
  p.y = take((size_t)NT * 1024);
  const size_t mark = off;
  p.rinvq = take(NT);
  p.rinvkv = take(NT);
  p.qa_raw = take((size_t)NT * 768);
  p.kv_raw = take((size_t)NT * 1024);
  p.QA = take((size_t)NT * 8 * 96);
  p.KA = take((size_t)NT * 8 * 96);
  p.QB = take((size_t)NT * 8 * 64);
  p.KB = take((size_t)NT * 2 * 64);
  const size_t end_att = off;
  off = mark;
  p.gq = take((size_t)NT * 512);
  p.gk = take((size_t)NT * 512);
  p.gv = take((size_t)NT * 512);
  p.gbeta = take((size_t)NT * 8);
  p.gg = take((size_t)NT * 8);
  p.xl = take((size_t)NT * 512);
  p.la = take((size_t)2 * NT * 512);
  p.lb = take((size_t)2 * NT * 512);
  p.odir = take((size_t)2 * NT * 512);
  p.rdir = take((size_t)2 * NT * 512);
  return (off > end_att ? off : end_att) * sizeof(float);
}

#endif

#ifndef HOST_TEST
typedef __attribute__((ext_vector_type(8))) __bf16 bf8_t;
typedef __attribute__((ext_vector_type(4))) __bf16 bf4_t;
typedef __attribute__((ext_vector_type(16))) float f32x16;
typedef unsigned short bf16_t;
constexpr int NALL = NB * NT;
constexpr int LDT = 72;
constexpr int GEMM_LDS = 2 * 2 * 128 * 64 * 2;
constexpr float LOG2E = 1.4426950408889634f;
constexpr int LDS_BYTES = 79872;
constexpr int XB_LDS_OFF = LDS_BYTES - 16;
constexpr int NCH = NT / 64;
constexpr int NCH_LAT = SEQ / 64;
#define XCD_BAR_WORDS 3456
constexpr size_t ws_al(size_t x) { return (x + 255) & ~(size_t)255; }
struct WsOff {
  static constexpr size_t bar = 0;
  static constexpr size_t bar_end = bar + ws_al(XCD_BAR_WORDS * 4);
  static constexpr size_t modv = bar_end;
  static constexpr size_t modv_end = modv + ws_al(4 * MODROWS * 3072 * 4);
  static constexpr size_t ropeG = modv_end;
  static constexpr size_t ropeG_end = ropeG + ws_al(64 * 16 * 2 * 4);
  static constexpr size_t ropeM = ropeG_end;
  static constexpr size_t ropeM_end = ropeM + ws_al(64 * 8 * 2 * 4);
  static constexpr size_t Xctx = ropeM_end;
  static constexpr size_t Xctx_end = Xctx + ws_al((size_t)NB * CTX * D * 4);
  static constexpr size_t WtIn = Xctx_end;
  static constexpr size_t WtIn_end = WtIn + ws_al((size_t)REC_NPAD * D * 2);
  static constexpr size_t Wuq = WtIn_end;
  static constexpr size_t Wuq_end = Wuq + ws_al((size_t)2 * 768 * 256 * 2);
  static constexpr size_t Wukv = Wuq_end;
  static constexpr size_t Wukv_end = Wukv + ws_al((size_t)2 * 1024 * 128 * 2);
  static constexpr size_t WG = Wukv_end;
  static constexpr size_t WG_end = WG + ws_al((size_t)64 * 4096 * 2);
  static constexpr size_t LHIN = WG_end;
  static constexpr size_t LHIN_end = LHIN + ws_al((size_t)NB * 2 * NCH * 512 * 4);
  static constexpr size_t LNS = LHIN_end;
  static constexpr size_t LNS_end = LNS + ws_al((size_t)NALL * 2 * 4);
  static constexpr size_t GCB = LNS_end;
  static constexpr size_t GCB_end = GCB + ws_al((size_t)NB * 2 * 4 * NT * 2 * 4);
  static constexpr size_t LCAR = GCB_end;
  static constexpr size_t LCAR_end = LCAR + ws_al((size_t)NB * 2 * NCH * 512 * 2 * 4);
  static constexpr size_t H = LCAR_end;
  static constexpr size_t H_end = H + ws_al((size_t)NALL * D * 2);
  static constexpr size_t ATTG = H;
  static constexpr size_t TG = H + (size_t)NB * NCH * 4 * 2 * 4096 * 2;
  static constexpr size_t mixh = H_end;
  static constexpr size_t mixh_end = mixh + ws_al((size_t)NALL * D * 2);
  static constexpr size_t mark_ = mixh_end;
  static constexpr size_t CQ = mixh_end;
  static constexpr size_t CQ_end = CQ + ws_al((size_t)NALL * 256 * 2);
  static constexpr size_t CKV = CQ_end;
  static constexpr size_t CKV_end = CKV + ws_al((size_t)NALL * 128 * 2);
  static constexpr size_t sqq = CKV_end;
  static constexpr size_t sqq_end = sqq + ws_al((size_t)NALL * 4 * 4);
  static constexpr size_t sqkv = sqq_end;
  static constexpr size_t sqkv_end = sqkv + ws_al((size_t)NALL * 2 * 4);
  static constexpr size_t QG = sqkv_end;
  static constexpr size_t QG_end = QG + ws_al((size_t)NALL * 512 * 2);
  static constexpr size_t KG = QG_end;
  static constexpr size_t KG_end = KG + ws_al((size_t)NALL * 128 * 2);
  static constexpr size_t VTG = KG_end;
  static constexpr size_t VTG_end = VTG + ws_al((size_t)NB * 2 * 64 * NT * 2);
  static constexpr size_t KRb = VTG_end;
  static constexpr size_t KRb_end = KRb + ws_al((size_t)NALL * 32 * 2);
  static constexpr size_t GAB = KRb_end;
  static constexpr size_t GAB_end = GAB + ws_al((size_t)NALL * 1024 * 2);
  static constexpr size_t QN = GAB_end;
  static constexpr size_t QN_end = QN + ws_al((size_t)NALL * 512 * 2);
  static constexpr size_t QR = QN_end;
  static constexpr size_t QR_end = QR + ws_al((size_t)NALL * 256 * 2);
  static constexpr size_t KN = QR_end;
  static constexpr size_t KN_end = KN + ws_al((size_t)NALL * 512 * 2);
  static constexpr size_t VTA = KN_end;
  static constexpr size_t VTA_end = VTA + ws_al((size_t)NB * 8 * 64 * NT * 2);
  static constexpr size_t endatt_ = VTA_end;
  static constexpr size_t PQKV = mark_;
  static constexpr size_t PQKV_end = PQKV + ws_al((size_t)NALL * 1536 * 2);
  static constexpr size_t PZG = PQKV_end;
  static constexpr size_t PZG_end = PZG + ws_al((size_t)NALL * 1024 * 2);
  static constexpr size_t PXR = PZG_end;
  static constexpr size_t PXR_end = PXR + ws_al((size_t)NALL * 512 * 2);
  static constexpr size_t PBA = PXR_end;
  static constexpr size_t PBA_end = PBA + ws_al((size_t)NALL * 16 * 4);
  static constexpr size_t GQ = PBA_end;
  static constexpr size_t GQ_end = GQ + ws_al((size_t)NALL * 512 * 2);
  static constexpr size_t GK = GQ_end;
  static constexpr size_t GK_end = GK + ws_al((size_t)NALL * 512 * 2);
  static constexpr size_t GV = GK_end;
  static constexpr size_t GV_end = GV + ws_al((size_t)NALL * 512 * 2);
  static constexpr size_t OD1 = GV_end;
  static constexpr size_t OD1_end = OD1 + ws_al((size_t)NALL * 512 * 2);
  static constexpr size_t endrec_ = OD1_end;
  static constexpr size_t total = endatt_ > endrec_ ? endatt_ : endrec_;
};


__device__ __forceinline__ int acc_row(int reg, int lane) { return (reg & 3) + 8 * (reg >> 2) + 4 * (lane >> 5); }
__device__ __forceinline__ float bf2f(bf16_t v) { return __uint_as_float((unsigned)v << 16); }
__device__ __forceinline__ uint2 pack4(float a, float b, float c, float d) {
  bf4_t v; v[0] = (__bf16)a; v[1] = (__bf16)b; v[2] = (__bf16)c; v[3] = (__bf16)d;
  return *(uint2*)&v;
}
__device__ __forceinline__ bf16_t f2bf_dev(float a) { __bf16 v = (__bf16)a; return *(bf16_t*)&v; }
__device__ __forceinline__ Params phase_params(const Params& q) {
  Params r = q;
  size_t zero = 0;
  asm volatile("" : "+s"(zero));
  r.ws = q.ws + zero;
  return r;
}
__device__ __forceinline__ int wave_index() {
  int wv = __builtin_amdgcn_readfirstlane((int)(threadIdx.x >> 6));
  asm volatile("" : "+s"(wv));
  return wv;
}
__device__ __forceinline__ int opaque_tid(int wv) {
  int lane;
  asm volatile("v_mbcnt_lo_u32_b32 %0, -1, 0\n\tv_mbcnt_hi_u32_b32 %0, -1, %0" : "=v"(lane));
  return (wv << 6) | lane;
}
__device__ __forceinline__ float silu_fast(float g) { return g / (1.0f + __expf(-g)); }


#define XB_TMO      128
#define XB_XCNT(j)  (256  + 64 * (j))
#define XB_XSUB(j)  (1280 + 64 * (j))
#define XB_XGEN(j)  (2304 + 64 * (j))
#define XB_TOP      3328
#define XB_TOPGEN   3392
#define XB_SPIN_CAP (1u << 22)
__device__ __forceinline__ unsigned xb_ld(unsigned* p) { return __hip_atomic_load(p, __ATOMIC_RELAXED, __HIP_MEMORY_SCOPE_AGENT); }
__device__ __forceinline__ unsigned xb_add(unsigned* p, unsigned v) { return __hip_atomic_fetch_add(p, v, __ATOMIC_RELAXED, __HIP_MEMORY_SCOPE_AGENT); }
__device__ __forceinline__ unsigned xb_xcc_id() { return (unsigned)__builtin_amdgcn_s_getreg((3 << 11) | 20) & 0xFu; }
#define XB_SPIN(cond, bar) do { unsigned _sp = 0; while (cond) { __builtin_amdgcn_s_sleep(1); \
    if ((++_sp & 255u) == 0u) { if (xb_ld(&(bar)[XB_TMO])) break; if (_sp > XB_SPIN_CAP) { atomicAdd(&(bar)[XB_TMO], 1u); break; } } } } while (0)
__device__ __forceinline__ void xcd_barrier_post(unsigned* bar, int tid) {
  if (tid == 0) (void)xb_add(&bar[XB_XCNT(xb_xcc_id())], 1u);
}
__device__ __forceinline__ void xcd_barrier_complete(unsigned* bar, unsigned x, unsigned& nloc, unsigned& nx) {
  const unsigned G = gridDim.x;
  unsigned sum, cnt, mine, sp = 0u;
  for (;;) {
    sum = 0u; cnt = 0u; mine = 0u;
#pragma unroll
    for (unsigned j = 0; j < 16; ++j) { const unsigned c = xb_ld(&bar[XB_XCNT(j)]); sum += c; cnt += (c > 0u) ? 1u : 0u; mine = (j == x) ? c : mine; }
    if (sum == G) break;
    __builtin_amdgcn_s_sleep(1);
    if ((++sp & 255u) == 0u) { if (xb_ld(&bar[XB_TMO])) break; if (sp > XB_SPIN_CAP) { atomicAdd(&bar[XB_TMO], 1u); break; } }
  }
  nloc = mine > 0u ? mine : 1u; nx = cnt > 0u ? cnt : 1u;
}
__device__ __forceinline__ void xcd_barrier(unsigned* bar, int tid) {
  volatile __attribute__((address_space(3))) unsigned* st = (volatile __attribute__((address_space(3))) unsigned*)(size_t)XB_LDS_OFF;
  asm volatile("s_waitcnt vmcnt(0)" ::: "memory");
  __syncthreads();
  if (tid == 0) {
    __builtin_amdgcn_s_waitcnt(0);
    const unsigned x = xb_xcc_id();
    unsigned nloc = st[0], nx = st[1];
    if (nloc == 0u) { xcd_barrier_complete(bar, x, nloc, nx); st[0] = nloc; st[1] = nx; }
    const unsigned old = xb_add(&bar[XB_XSUB(x)], 1u);
    const unsigned gen = old / nloc;
    if (old + 1u == (gen + 1u) * nloc) {
      __builtin_amdgcn_fence(__ATOMIC_RELEASE, "agent");
      asm volatile("s_waitcnt vmcnt(0)" ::: "memory");
      const unsigned og = xb_add(&bar[XB_TOP], 1u);
      const unsigned tg = og / nx;
      if (og + 1u == (tg + 1u) * nx) xb_add(&bar[XB_TOPGEN], 1u);
      else XB_SPIN(xb_ld(&bar[XB_TOPGEN]) == tg, bar);
      __builtin_amdgcn_fence(__ATOMIC_ACQUIRE, "agent");
      xb_add(&bar[XB_XGEN(x)], 1u);
      asm volatile("s_waitcnt vmcnt(0)" ::: "memory");
    } else {
      XB_SPIN(xb_ld(&bar[XB_XGEN(x)]) == gen, bar);
      __builtin_amdgcn_fence(__ATOMIC_ACQUIRE, "agent");
      asm volatile("s_waitcnt vmcnt(0)" ::: "memory");
    }
  }
  __syncthreads();
}


__device__ __forceinline__ int next_unit(unsigned* ctr, char* smem, int tid) {
  volatile int* slot = (volatile int*)(smem + XB_LDS_OFF + 8);
  __syncthreads();
  if (tid == 0) *slot = (int)__hip_atomic_fetch_add(ctr, 1u, __ATOMIC_RELAXED, __HIP_MEMORY_SCOPE_AGENT);
  __syncthreads();
  return *slot;
}


__device__ __forceinline__ void signal_add(unsigned* ctr, unsigned v, int tid) {
  asm volatile("s_waitcnt vmcnt(0)" ::: "memory");
  __syncthreads();
  if (tid == 0) {
    __builtin_amdgcn_fence(__ATOMIC_RELEASE, "agent");
    asm volatile("s_waitcnt vmcnt(0)" ::: "memory");
    (void)__hip_atomic_fetch_add(ctr, v, __ATOMIC_RELAXED, __HIP_MEMORY_SCOPE_AGENT);
  }
}
__device__ __forceinline__ void wait_ge(unsigned* ctr, unsigned target, int tid) {
  if (tid == 0) {
    unsigned spins = 0;
    while (__hip_atomic_load(ctr, __ATOMIC_RELAXED, __HIP_MEMORY_SCOPE_AGENT) < target) {
      __builtin_amdgcn_s_sleep(16);
      if (++spins > (1u << 24)) break;
    }
    __builtin_amdgcn_fence(__ATOMIC_ACQUIRE, "agent");
    asm volatile("s_waitcnt vmcnt(0)" ::: "memory");
  }
  __syncthreads();
}

__device__ __forceinline__ void gemm_tile_core(const bf16_t* A, int lda, const bf16_t* Wt,
                                               int ldw, int K, int m0, int n0, char* smem, bool tr,
                                               f32x16 (&acc)[2][2], int tid) {
  bf16_t* As = (bf16_t*)smem;
  bf16_t* Bs = As + 2 * 128 * 64;
  const int lane = tid & 63, w = tid >> 6, wr = w >> 1, wc = w & 1;
  const int lr = tid >> 3;
  const int lc = (((tid & 7) ^ ((tid >> 4) & 7))) * 8;
  const bf16_t* ga = A + (size_t)(m0 + lr) * lda + lc;
  const bf16_t* gb = Wt + (size_t)(n0 + lr) * ldw + lc;
#define GEMM_DMA(BUF, KOFF)                                                                                         \
  {                                                                                                                 \
    _Pragma("unroll") for (int i_ = 0; i_ < 4; ++i_) {                                                              \
      __builtin_amdgcn_global_load_lds((const unsigned*)(ga + (size_t)(32 * i_) * lda + (KOFF)),                    \
                                       (unsigned*)(As + (BUF) * 8192 + tid * 8 + i_ * 2048), 16, 0, 0);             \
      __builtin_amdgcn_global_load_lds((const unsigned*)(gb + (size_t)(32 * i_) * ldw + (KOFF)),                    \
                                       (unsigned*)(Bs + (BUF) * 8192 + tid * 8 + i_ * 2048), 16, 0, 0);             \
    }                                                                                                               \
  }
  GEMM_DMA(0, 0);
#pragma unroll
  for (int i = 0; i < 2; ++i)
#pragma unroll
    for (int j = 0; j < 2; ++j)
#pragma unroll
      for (int r = 0; r < 16; ++r) acc[i][j][r] = 0.f;
  asm volatile("s_waitcnt vmcnt(0)" ::: "memory");
  __syncthreads();
  const int nk = K >> 6;
  const int xr0 = ((tr ? wc : wr) * 64 + (lane & 31)) * 64;
  const int yr0 = ((tr ? wr : wc) * 64 + (lane & 31)) * 64;
  const int m7 = (lane >> 1) & 7, hh = lane >> 5;
  for (int kt = 0; kt < nk; ++kt) {
    const int cur = kt & 1;
    if (kt + 1 < nk) GEMM_DMA(cur ^ 1, (kt + 1) * 64);
    const bf16_t* Xs = (tr ? Bs : As) + cur * 8192 + xr0;
    const bf16_t* Ys = (tr ? As : Bs) + cur * 8192 + yr0;
    __builtin_amdgcn_s_setprio(1);
#pragma unroll
    for (int ks = 0; ks < 4; ++ks) {
      const int co = (((2 * ks + hh) ^ m7)) * 8;
      const bf8_t x0 = *(const bf8_t*)(Xs + co);
      const bf8_t x1 = *(const bf8_t*)(Xs + 32 * 64 + co);
      const bf8_t y0 = *(const bf8_t*)(Ys + co);
      const bf8_t y1 = *(const bf8_t*)(Ys + 32 * 64 + co);
      acc[0][0] = __builtin_amdgcn_mfma_f32_32x32x16_bf16(x0, y0, acc[0][0], 0, 0, 0);
      acc[0][1] = __builtin_amdgcn_mfma_f32_32x32x16_bf16(x0, y1, acc[0][1], 0, 0, 0);
      acc[1][0] = __builtin_amdgcn_mfma_f32_32x32x16_bf16(x1, y0, acc[1][0], 0, 0, 0);
      acc[1][1] = __builtin_amdgcn_mfma_f32_32x32x16_bf16(x1, y1, acc[1][1], 0, 0, 0);
    }
    __builtin_amdgcn_s_setprio(0);
    asm volatile("s_waitcnt vmcnt(0)" ::: "memory");
    __syncthreads();
  }
#undef GEMM_DMA
}

struct TileWalk {
  int m0, nrows, c0, ncols, t, step, count;
  __device__ __forceinline__ TileWalk(int MT, int NTL) {
    const int xcd = blockIdx.x & 7, xr = xcd >> 1, xc = xcd & 1;
    const int q = MT >> 2, rem = MT & 3;
    m0 = xr * q + (xr < rem ? xr : rem);
    nrows = q + (xr < rem ? 1 : 0);
    const int half = (NTL + 1) >> 1;
    c0 = xc ? half : 0;
    ncols = xc ? NTL - half : half;
    t = blockIdx.x >> 3;
    step = gridDim.x >> 3;
    count = nrows * ncols;
  }
  __device__ __forceinline__ bool valid() const { return t < count; }
  __device__ __forceinline__ void next() { t += step; }
  __device__ __forceinline__ int mt() const { return m0 + t / ncols; }
  __device__ __forceinline__ int nt() const { return c0 + t % ncols; }
};

struct GemmM { const bf16_t* A; int lda; const bf16_t* Wt; int ldw; int K; int mtiles; int ntiles; float* C; int ldc; int N; };
__device__ void mgemm_phase(const GemmM& g, char* smem, int wv) {
  const int tid = opaque_tid(wv);
  const int lane = tid & 63, w = tid >> 6, wr = w >> 1, wc = w & 1;
  for (int u = blockIdx.x; u < g.mtiles * g.ntiles; u += gridDim.x) {
    const int mt = u / g.ntiles, nt = u % g.ntiles;
    f32x16 acc[2][2];
    gemm_tile_core(g.A, g.lda, g.Wt, g.ldw, g.K, mt * 128, nt * 128, smem, false, acc, tid);
#pragma unroll
    for (int i = 0; i < 2; ++i)
#pragma unroll
      for (int j = 0; j < 2; ++j) {
        const int col = nt * 128 + wc * 64 + j * 32 + (lane & 31);
        if (col < g.N) {
#pragma unroll
          for (int r = 0; r < 16; ++r) {
            const int row = mt * 128 + wr * 64 + i * 32 + acc_row(r, lane);
            g.C[(size_t)row * g.ldc + col] = acc[i][j][r];
          }
        }
      }
  }
}

__device__ __forceinline__ int att_colmap(int n) {
  if (n < 256) return A_CQ + n;
  if (n < 384) return A_CKV + (n - 256);
  if (n < 896) return A_QB + (n - 384);
  if (n < 1024) return A_KB + (n - 896);
  if (n < 1152) return A_VB + (n - 1024);
  if (n < 1184) return A_KR + (n - 1152);
  if (n < 1216) return -1;
  if (n < 1728) return A_GA + (n - 1216);
  if (n < 2240) return A_GB + (n - 1728);
  return -1;
}
__device__ __forceinline__ int rec_colmap(int n) {
  if (n < 1536) return R_QKV + n;
  if (n < 2048) return R_Z + (n - 1536);
  if (n < 2560) return R_GR + (n - 2048);
  if (n < 3072) return R_XR + (n - 2560);
  if (n < 3088) return R_B + (n - 3072);
  return -1;
}
__device__ __forceinline__ int uq_colmap(int n) {
  if (n < 512) return (n >> 6) * 96 + (n & 63);
  const int e = n - 512;
  return (e >> 5) * 96 + 64 + (e & 31);
}
__device__ __forceinline__ int ukv_colmap(int n) {
  if (n < 512) return (n >> 6) * 128 + (n & 63);
  const int e = n - 512;
  return (e >> 6) * 128 + 64 + (e & 63);
}
__device__ __forceinline__ void wconv2_item(const float* src, int nsrc, int K, bf16_t* dst, int mode, const float* kscale,
                                            long i) {
  const int kgs = K >> 4;
  const int kg = (int)(i % kgs);
  const int n = (int)(i / kgs);
  int col = n;
  if (mode == 1) col = att_colmap(n);
  else if (mode == 2) col = uq_colmap(n);
  else if (mode == 3) col = ukv_colmap(n);
  else if (mode == 4) col = rec_colmap(n);
  if (col >= nsrc) col = -1;
  unsigned* d32 = (unsigned*)(dst + (size_t)n * K + kg * 16);
  unsigned zero = 0;
  asm volatile("" : "+v"(zero));
#pragma unroll
  for (int t = 0; t < 8; ++t) {
    unsigned lo = zero, hi = zero;
    if (col >= 0) {
      const int k0 = kg * 16 + 2 * t;
      float a = src[(size_t)k0 * nsrc + col], b = src[(size_t)(k0 + 1) * nsrc + col];
      if (kscale) { a *= kscale[k0]; b *= kscale[k0 + 1]; }
      lo = f2bf_dev(a); hi = f2bf_dev(b);
    }
    d32[t] = lo | (hi << 16);
  }
}
__device__ __forceinline__ void mod_item_dev(const Params& p, long i) {
  const int j = (int)(i % 3072);
  const int r = (int)((i / 3072) % MODROWS);
  const int l = (int)(i / (3072 * MODROWS));
  const float* cv = r < NB ? p.c + (size_t)r * D : p.c_ctx + 0;
  const float* w = p.mod_w + (size_t)l * D * 3072 + j;
  float acc = 0.f;
  for (int k = 0; k < D; ++k) acc += siluf_(cv[k]) * w[(size_t)k * 3072];
  ((float*)(p.ws + WsOff::modv))[i] = acc + p.mod_b[l * 3072 + j];
}
__device__ __forceinline__ void wconv_tile(const float* src, int nsrc, int K, bf16_t* dst, int mode, const float* kscale,
                                           int n0, int k0, char* smem, int tid) {
  bf16_t* T = (bf16_t*)smem;
  const int nn = tid & 63, kk = tid >> 6;
  const int n = n0 + nn;
  int col = n;
  if (mode == 1) col = att_colmap(n);
  else if (mode == 2) col = uq_colmap(n);
  else if (mode == 3) col = ukv_colmap(n);
  else if (mode == 4) col = rec_colmap(n);
  if (col >= nsrc) col = -1;
#pragma unroll 4
  for (int ps = 0; ps < 16; ++ps) {
    const int k = ps * 4 + kk;
    float v = 0.f;
    if (col >= 0) {
      v = src[(size_t)(k0 + k) * nsrc + col];
      if (kscale) v *= kscale[k0 + k];
    }
    T[nn * 66 + k] = f2bf_dev(v);
  }
  __syncthreads();
  {
    const int row = tid >> 2, part = tid & 3;
    const unsigned* t32 = (const unsigned*)(T + row * 66 + part * 16);
    uint4 a, b;
    a.x = t32[0]; a.y = t32[1]; a.z = t32[2]; a.w = t32[3];
    b.x = t32[4]; b.y = t32[5]; b.z = t32[6]; b.w = t32[7];
    bf16_t* d = dst + (size_t)(n0 + row) * K + k0 + part * 16;
    *(uint4*)d = a;
    *(uint4*)(d + 8) = b;
  }
  __syncthreads();
}
__device__ __forceinline__ int wconv_matrix(const float* src, int nsrc, int rows, int K, bf16_t* dst, int mode,
                                            const float* kscale, int u0, char* smem, int tid) {
  const int kt = K >> 6, nt = rows >> 6;
  const int total = kt * nt;
  int u = (int)blockIdx.x - (u0 % (int)gridDim.x);
  if (u < 0) u += gridDim.x;
  for (; u < total; u += gridDim.x) wconv_tile(src, nsrc, K, dst, mode, kscale, (u / kt) * 64, (u % kt) * 64, smem, tid);
  return u0 + total;
}
__device__ __forceinline__ void convert_outproj(const Params& p, int layer, char* smem, int tid) {
  const float* src = (layer & 1) == 0 ? p.att_w_out + (size_t)(layer >> 1) * D * D : p.rec_w_out + (size_t)(layer >> 1) * D * D;
  (void)wconv_matrix(src, D, D, D, ((bf16_t*)(p.ws + WsOff::WtIn)), 0, nullptr, 0, smem, tid);
}
__device__ void mod_phase(const Params& p, char* smem, int tid) {
  float* sc = (float*)smem;
  float* red = sc + MODROWS * 1024;
  for (int i = tid; i < MODROWS * 1024; i += 256) {
    const int r = i >> 10, k = i & 1023;
    const float c = r < NB ? p.c[(size_t)r * D + k] : p.c_ctx[k];
    sc[i] = c / (1.0f + __expf(-c));
  }
  __syncthreads();
  const int jj = tid & 31, kg = tid >> 5;
  for (int u = blockIdx.x; u < 4 * 96; u += gridDim.x) {
    const int l = u / 96, j = (u % 96) * 32 + jj;
    const float* w = p.mod_w + (size_t)l * D * 3072 + (size_t)(kg * 128) * 3072 + j;
    float acc[MODROWS];
#pragma unroll
    for (int r = 0; r < MODROWS; ++r) acc[r] = 0.f;
#pragma unroll 8
    for (int k = 0; k < 128; ++k) {
      const float wv_ = w[(size_t)k * 3072];
#pragma unroll
      for (int r = 0; r < MODROWS; ++r) acc[r] += sc[r * 1024 + kg * 128 + k] * wv_;
    }
#pragma unroll
    for (int r = 0; r < MODROWS; ++r) red[(kg * MODROWS + r) * 32 + jj] = acc[r];
    __syncthreads();
    if (tid < MODROWS * 32) {
      const int r = tid >> 5, c = tid & 31;
      float t = 0.f;
#pragma unroll
      for (int g = 0; g < 8; ++g) t += red[(g * MODROWS + r) * 32 + c];
      const int jo = (u % 96) * 32 + c;
      ((float*)(p.ws + WsOff::modv))[((size_t)l * MODROWS + r) * 3072 + jo] = t + p.mod_b[l * 3072 + jo];
    }
    __syncthreads();
  }
}

__device__ __forceinline__ void rope_table_item(const Params& p, int i) {
  if (i < 64 * 16) {
    const int pos = i >> 4, f = i & 15;
    const float ang = (float)pos * powf(10000.0f, -(float)(2 * f) / 32.0f);
    ((float*)(p.ws + WsOff::ropeG))[2 * i] = cosf(ang); ((float*)(p.ws + WsOff::ropeG))[2 * i + 1] = sinf(ang);
  } else {
    const int k = i - 64 * 16;
    const int pos = k >> 3, f = k & 7;
    const float ang = (float)pos * powf(10000.0f, -(float)(2 * f) / 16.0f);
    ((float*)(p.ws + WsOff::ropeM))[2 * k] = cosf(ang); ((float*)(p.ws + WsOff::ropeM))[2 * k + 1] = sinf(ang);
  }
}

__device__ __forceinline__ void store_T64(bf16_t* dstrow, const f32x16& a0, const f32x16& a1, int lane) {
  const int h4 = (lane >> 5) * 4;
#pragma unroll
  for (int q = 0; q < 4; ++q) {
    *(uint2*)(dstrow + 8 * q + h4) = pack4(a0[4 * q], a0[4 * q + 1], a0[4 * q + 2], a0[4 * q + 3]);
    *(uint2*)(dstrow + 32 + 8 * q + h4) = pack4(a1[4 * q], a1[4 * q + 1], a1[4 * q + 2], a1[4 * q + 3]);
  }
}
__device__ __forceinline__ float sumsq16(const f32x16& a) {
  float s = 0.f;
#pragma unroll
  for (int r = 0; r < 16; ++r) s += a[r] * a[r];
  return s;
}
__device__ __forceinline__ void rope_gqa(f32x16& a, const float* tab  , int lane) {
  const int h4 = (lane >> 5) * 4;
#pragma unroll
  for (int r = 0; r < 8; ++r) {
    const int i0 = (r & 3) + 8 * ((r >> 2) & 1) + h4;
    const float c = tab[2 * i0], s = tab[2 * i0 + 1];
    const float x1 = a[r], x2 = a[r + 8];
    a[r] = x1 * c - x2 * s;
    a[r + 8] = x1 * s + x2 * c;
  }
}
__device__ __forceinline__ void rope_mla(f32x16& a, const float* tabr  , const float* tabc, int lane) {
  const int h4 = (lane >> 5) * 4;
#pragma unroll
  for (int part = 0; part < 2; ++part) {
    const float* tab = part == 0 ? tabr : tabc;
#pragma unroll
    for (int e = 0; e < 4; ++e) {
      const int r = 8 * part + e;
      const int i0 = e + h4;
      const float c = tab[2 * i0], s = tab[2 * i0 + 1];
      const float x1 = a[r], x2 = a[r + 4];
      a[r] = x1 * c - x2 * s;
      a[r + 4] = x1 * s + x2 * c;
    }
  }
}

__device__ void att_inproj_phase(const Params& p_, int layer, char* smem, int wv) {
  const Params p = phase_params(p_);
  const int li = layer >> 1;
  const int tid = opaque_tid(wv);
  const int lane = tid & 63, w = tid >> 6, wr = w >> 1, wc = w & 1;
  const bf16_t* Wt = ((bf16_t*)(p.ws + WsOff::WtIn));
  constexpr int MT = NALL / 128, NTL = ATT_NPAD / 128;
  for (TileWalk tw(MT, NTL); tw.valid(); tw.next()) {
    const int mt = tw.mt(), nt = tw.nt();
    const int slab = 2 * nt + wc;
    const bool tr = slab < 19;
    f32x16 acc[2][2];
    gemm_tile_core(((bf16_t*)(p.ws + WsOff::H)), D, Wt, D, D, mt * 128, nt * 128, smem, tr, acc, tid);
    const int mbase = mt * 128 + wr * 64;
    const int b = (mt * 128) / NT;
    const int lt0 = mt * 128 - b * NT + wr * 64;
    const bool lat = lt0 < SEQ;
    if (slab < 6) {
#pragma unroll
      for (int j = 0; j < 2; ++j) {
        const int gt = mbase + j * 32 + (lane & 31);
        float ss = sumsq16(acc[0][j]) + sumsq16(acc[1][j]);
        ss += __shfl_xor(ss, 32);
        bf16_t* dst = slab < 4 ? ((bf16_t*)(p.ws + WsOff::CQ)) + (size_t)gt * 256 + slab * 64 : ((bf16_t*)(p.ws + WsOff::CKV)) + (size_t)gt * 128 + (slab - 4) * 64;
        store_T64(dst, acc[0][j], acc[1][j], lane);
        if (lane < 32) {
          if (slab < 4) ((float*)(p.ws + WsOff::sqq))[(size_t)gt * 4 + slab] = ss;
          else ((float*)(p.ws + WsOff::sqkv))[(size_t)gt * 2 + (slab - 4)] = ss;
        }
      }
    } else if (slab < 16) {
      const bool isq = slab < 14;
      const int head = isq ? slab - 6 : slab - 14;
      const float* nw = (isq ? p.gqa_q_norm + 0 : p.gqa_k_norm + 0) + li * 64;
      const float post = isq ? 0.125f * LOG2E : 1.0f;
#pragma unroll
      for (int j = 0; j < 2; ++j) {
        const int gt = mbase + j * 32 + (lane & 31);
        const int lt = lt0 + j * 32 + (lane & 31);
        float ss = sumsq16(acc[0][j]) + sumsq16(acc[1][j]);
        ss += __shfl_xor(ss, 32);
        const float rinv = rsqrtf(ss * (1.0f / 64.0f) + EPS) * post;
#pragma unroll
        for (int i = 0; i < 2; ++i)
#pragma unroll
          for (int r = 0; r < 16; ++r) acc[i][j][r] *= rinv * nw[i * 32 + acc_row(r, lane)];
        if (lat) {
          rope_gqa(acc[0][j], ((float*)(p.ws + WsOff::ropeG)) + (lt >> 6) * 32, lane);
          rope_gqa(acc[1][j], ((float*)(p.ws + WsOff::ropeG)) + (lt & 63) * 32, lane);
        }
        bf16_t* dst = isq ? ((bf16_t*)(p.ws + WsOff::QG)) + (size_t)gt * 512 + head * 64 : ((bf16_t*)(p.ws + WsOff::KG)) + (size_t)gt * 128 + head * 64;
        store_T64(dst, acc[0][j], acc[1][j], lane);
      }
    } else if (slab < 18) {
      const int kvh = slab - 16;
#pragma unroll
      for (int j = 0; j < 2; ++j) {
        const int lt = lt0 + j * 32 + (lane & 31);
        bf16_t* dst = ((bf16_t*)(p.ws + WsOff::VTG)) + ((size_t)(b * 2 + kvh) * 64) * NT + lt;
#pragma unroll
        for (int i = 0; i < 2; ++i)
#pragma unroll
          for (int r = 0; r < 16; ++r) dst[(size_t)(i * 32 + acc_row(r, lane)) * NT] = f2bf_dev(acc[i][j][r]);
      }
    } else if (slab == 18) {
#pragma unroll
      for (int j = 0; j < 2; ++j) {
        const int gt = mbase + j * 32 + (lane & 31);
        const int lt = lt0 + j * 32 + (lane & 31);
        if (lat) rope_mla(acc[0][j], ((float*)(p.ws + WsOff::ropeM)) + (lt >> 6) * 16, ((float*)(p.ws + WsOff::ropeM)) + (lt & 63) * 16, lane);
        bf16_t* dst = ((bf16_t*)(p.ws + WsOff::KRb)) + (size_t)gt * 32 + (lane >> 5) * 4;
#pragma unroll
        for (int q = 0; q < 4; ++q)
          *(uint2*)(dst + 8 * q) = pack4(acc[0][j][4 * q], acc[0][j][4 * q + 1], acc[0][j][4 * q + 2], acc[0][j][4 * q + 3]);
      }
    } else if (slab < 35) {
      const int cbase = (slab - 19) * 64;
#pragma unroll
      for (int i = 0; i < 2; ++i)
#pragma unroll
        for (int j = 0; j < 2; ++j)
#pragma unroll
          for (int r = 0; r < 16; ++r) {
            const int gt = mbase + i * 32 + acc_row(r, lane);
            ((bf16_t*)(p.ws + WsOff::GAB))[(size_t)gt * 1024 + cbase + j * 32 + (lane & 31)] = f2bf_dev(acc[i][j][r]);
          }
    }
  }
}

__device__ void upproj_phase(const Params& p_, int layer, char* smem, int wv) {
  const Params p = phase_params(p_);
  convert_outproj(p, layer, smem, opaque_tid(wv));
  const int li = layer >> 1;
  const int tid = opaque_tid(wv);
  const int lane = tid & 63, w = tid >> 6, wr = w >> 1, wc = w & 1;
  constexpr int MT = NALL / 128;
  constexpr int NTQ = 768 / 128, NTKV = 1024 / 128;
  const bf16_t* Wq = ((bf16_t*)(p.ws + WsOff::Wuq)) + (size_t)li * 768 * 256;
  const bf16_t* Wkv = ((bf16_t*)(p.ws + WsOff::Wukv)) + (size_t)li * 1024 * 128;
  const float qscale = 0.10206207261596575f * LOG2E;
  for (TileWalk tw(MT, NTQ + NTKV); tw.valid(); tw.next()) {
    const int mt = tw.mt();
    int nt = tw.nt();
    const bool isq = nt < NTQ;
    if (!isq) nt -= NTQ;
    const int slab = 2 * nt + wc;
    const bool tr = slab >= 8;
    f32x16 acc[2][2];
    if (isq) gemm_tile_core(((bf16_t*)(p.ws + WsOff::CQ)), 256, Wq, 256, 256, mt * 128, nt * 128, smem, tr, acc, tid);
    else gemm_tile_core(((bf16_t*)(p.ws + WsOff::CKV)), 128, Wkv, 128, 128, mt * 128, nt * 128, smem, tr, acc, tid);
    const int mbase = mt * 128 + wr * 64;
    const int b = (mt * 128) / NT;
    const int lt0 = mt * 128 - b * NT + wr * 64;
    const bool lat = lt0 < SEQ;
    if (!tr) {
      bf16_t* dstb = (isq ? ((bf16_t*)(p.ws + WsOff::QN)) + 0 : ((bf16_t*)(p.ws + WsOff::KN)) + 0) + slab * 64;
#pragma unroll
      for (int i = 0; i < 2; ++i)
#pragma unroll
        for (int r = 0; r < 16; ++r) {
          const int gt = mbase + i * 32 + acc_row(r, lane);
          float rs;
          if (isq) {
            const float4 sq = *(const float4*)(((float*)(p.ws + WsOff::sqq)) + (size_t)gt * 4);
            rs = rsqrtf((sq.x + sq.y + sq.z + sq.w) * (1.0f / 256.0f) + EPS) * qscale;
          } else {
            const float2 sq = *(const float2*)(((float*)(p.ws + WsOff::sqkv)) + (size_t)gt * 2);
            rs = rsqrtf((sq.x + sq.y) * (1.0f / 128.0f) + EPS);
          }
#pragma unroll
          for (int j = 0; j < 2; ++j)
            dstb[(size_t)gt * 512 + j * 32 + (lane & 31)] = f2bf_dev(acc[i][j][r] * rs);
        }
    } else {
#pragma unroll
      for (int j = 0; j < 2; ++j) {
        const int gt = mbase + j * 32 + (lane & 31);
        const int lt = lt0 + j * 32 + (lane & 31);
        if (isq) {
          const float4 sq = *(const float4*)(((float*)(p.ws + WsOff::sqq)) + (size_t)gt * 4);
          const float rs = rsqrtf((sq.x + sq.y + sq.z + sq.w) * (1.0f / 256.0f) + EPS) * qscale;
#pragma unroll
          for (int i = 0; i < 2; ++i) {
#pragma unroll
            for (int r = 0; r < 16; ++r) acc[i][j][r] *= rs;
            if (lat) rope_mla(acc[i][j], ((float*)(p.ws + WsOff::ropeM)) + (lt >> 6) * 16, ((float*)(p.ws + WsOff::ropeM)) + (lt & 63) * 16, lane);
          }
          store_T64(((bf16_t*)(p.ws + WsOff::QR)) + (size_t)gt * 256 + (slab - 8) * 64, acc[0][j], acc[1][j], lane);
        } else {
          const float2 sq = *(const float2*)(((float*)(p.ws + WsOff::sqkv)) + (size_t)gt * 2);
          const float rs = rsqrtf((sq.x + sq.y) * (1.0f / 128.0f) + EPS);
          bf16_t* dst = ((bf16_t*)(p.ws + WsOff::VTA)) + ((size_t)(b * 8 + (slab - 8)) * 64) * NT + lt;
#pragma unroll
          for (int i = 0; i < 2; ++i)
#pragma unroll
            for (int r = 0; r < 16; ++r) dst[(size_t)(i * 32 + acc_row(r, lane)) * NT] = f2bf_dev(acc[i][j][r] * rs);
        }
      }
    }
  }
}

struct AttnUnit {
  unsigned q0, q0rb;
  unsigned q1, q1rb;
  unsigned k0, k0rb;
  unsigned k1, k1rb;
  unsigned vt;
  unsigned gate, out;
  int gt_base;
  int kt0, kt1;
  int qlt;
  int tid;
};

__device__ __forceinline__ int swap23(int r) { return (r & ~12) | ((r & 4) << 1) | ((r & 8) >> 1); }
__device__ __forceinline__ float max3f(float a, float b, float c) {
  float r;
  asm("v_max3_f32 %0, %1, %2, %3" : "=v"(r) : "v"(a), "v"(b), "v"(c));
  return r;
}
typedef __attribute__((ext_vector_type(2))) float f32x2;

template <int DQK>
__device__ __forceinline__ void attention_unit(const AttnUnit& a, const char* ws, char* smem) {
  constexpr int KLD = DQK + 8;
  constexpr int VLD = 72;
  constexpr int KCH = DQK / 8;
  bf16_t* Ks = (bf16_t*)smem;
  bf16_t* Vs = Ks + 2 * 64 * KLD;
  const int tid = a.tid, lane = tid & 63;
  const int r31 = lane & 31, h8 = (lane >> 5) * 8;
  bf8_t qf[DQK / 16];
  {
    const unsigned gq = (unsigned)(a.gt_base + a.qlt);
#pragma unroll
    for (int s = 0; s < DQK / 16; ++s) {
      const int d0 = 16 * s + h8;
      if (s < 4) qf[s] = *(const bf8_t*)(ws + a.q0 + gq * a.q0rb + d0 * 2);
      else qf[s] = *(const bf8_t*)(ws + a.q1 + gq * a.q1rb + (d0 - 64) * 2);
    }
  }
  unsigned gk0, gk1, gk2 = 0, ik0, ik1, ik2 = 0, gv0, gv1;
  int lk0, lk1, lk2 = 0, lv0, lv1;
  {
    const unsigned g0 = (unsigned)(a.gt_base + a.kt0 * 64);
#define ATT_KSETUP(C_, GK, IK, LK)                                                              \
    {                                                                                             \
      const int id = tid + 256 * C_;                                                              \
      const int key = id / KCH, part = id % KCH;                                                  \
      const bool hi = DQK == 96 && part >= 8;                                                     \
      GK = hi ? a.k1 + (g0 + key) * a.k1rb + (part - 8) * 16 : a.k0 + (g0 + key) * a.k0rb + part * 16; \
      IK = 64u * (hi ? a.k1rb : a.k0rb);                                                          \
      LK = key * KLD + part * 8;                                                                  \
    }
    ATT_KSETUP(0, gk0, ik0, lk0)
    ATT_KSETUP(1, gk1, ik1, lk1)
    if (DQK == 96) ATT_KSETUP(2, gk2, ik2, lk2)
#undef ATT_KSETUP
    const int dvA = tid >> 3, part = tid & 7;
    gv0 = a.vt + (unsigned)dvA * (NT * 2) + (unsigned)(a.kt0 * 64) * 2 + part * 16;
    gv1 = gv0 + 32u * (NT * 2);
    lv0 = dvA * VLD + part * 8;
    lv1 = lv0 + 32 * VLD;
  }
  uint4 rk0, rk1, rk2 = make_uint4(0, 0, 0, 0), rv0, rv1;
#define ATT_LOAD()                                                                                \
  {                                                                                               \
    rk0 = *(const uint4*)(ws + gk0); rk1 = *(const uint4*)(ws + gk1);                             \
    if (DQK == 96) rk2 = *(const uint4*)(ws + gk2);                                               \
    rv0 = *(const uint4*)(ws + gv0); rv1 = *(const uint4*)(ws + gv1);                             \
    gk0 += ik0; gk1 += ik1; gk2 += ik2; gv0 += 128u; gv1 += 128u;                                 \
  }
#define ATT_STORE(BUF)                                                                            \
  {                                                                                               \
    *(uint4*)(Ks + (BUF) * 64 * KLD + lk0) = rk0; *(uint4*)(Ks + (BUF) * 64 * KLD + lk1) = rk1;   \
    if (DQK == 96) *(uint4*)(Ks + (BUF) * 64 * KLD + lk2) = rk2;                                  \
    *(uint4*)(Vs + (BUF) * 64 * VLD + lv0) = rv0; *(uint4*)(Vs + (BUF) * 64 * VLD + lv1) = rv1;   \
  }
  ATT_LOAD();
  ATT_STORE(0);
  __syncthreads();
#pragma unroll
  for (int s = 0; s < DQK / 16; ++s) asm volatile("" :: "v"(qf[s]));
  f32x16 o0, o1, negm;
#pragma unroll
  for (int r = 0; r < 16; ++r) { o0[r] = 0.f; o1[r] = 0.f; negm[r] = 0.f; }
  float l = 0.f;
  bool first = true;
  const int krow = swap23(r31) * KLD + h8;
  const int vrow = r31 * VLD + h8;
  for (int kt = a.kt0; kt < a.kt1; ++kt) {
    const int cur = (kt - a.kt0) & 1;
    if (kt + 1 < a.kt1) ATT_LOAD();
    asm volatile("" ::: "memory");
    __builtin_amdgcn_sched_barrier(0);
    const bf16_t* Kc = Ks + cur * 64 * KLD + krow;
    const bf16_t* Vc = Vs + cur * 64 * VLD + vrow;
    f32x16 s0, s1;
    {
      const bf8_t k0 = *(const bf8_t*)(Kc);
      const bf8_t k1 = *(const bf8_t*)(Kc + 32 * KLD);
      s0 = __builtin_amdgcn_mfma_f32_32x32x16_bf16(k0, qf[0], negm, 0, 0, 0);
      s1 = __builtin_amdgcn_mfma_f32_32x32x16_bf16(k1, qf[0], negm, 0, 0, 0);
    }
#pragma unroll
    for (int ks = 1; ks < DQK / 16; ++ks) {
      const bf8_t k0 = *(const bf8_t*)(Kc + ks * 16);
      const bf8_t k1 = *(const bf8_t*)(Kc + 32 * KLD + ks * 16);
      s0 = __builtin_amdgcn_mfma_f32_32x32x16_bf16(k0, qf[ks], s0, 0, 0, 0);
      s1 = __builtin_amdgcn_mfma_f32_32x32x16_bf16(k1, qf[ks], s1, 0, 0, 0);
    }
    float mx = max3f(s0[0], s1[0], s0[1]);
    mx = max3f(mx, s1[1], s0[2]);
#pragma unroll
    for (int r = 2; r < 15; ++r) mx = max3f(mx, s1[r], s0[r + 1]);
    mx = fmaxf(mx, s1[15]);
    mx = fmaxf(mx, __shfl_xor(mx, 32));
    if (first || __builtin_amdgcn_ballot_w64(mx > 4.0f) != 0ull) {
      const float d = first ? mx : fmaxf(mx, 0.f);
      const float alpha = first ? 0.f : __builtin_amdgcn_exp2f(-d);
      first = false;
      l *= alpha;
#pragma unroll
      for (int r = 0; r < 16; ++r) { o0[r] *= alpha; o1[r] *= alpha; negm[r] -= d; s0[r] -= d; s1[r] -= d; }
    }
    f32x2 ps2 = {0.f, 0.f};
#pragma unroll
    for (int r = 0; r < 16; ++r) {
      s0[r] = __builtin_amdgcn_exp2f(s0[r]);
      s1[r] = __builtin_amdgcn_exp2f(s1[r]);
      f32x2 t = {s0[r], s1[r]};
      ps2 += t;
    }
    l += ps2[0] + ps2[1];
    {
      bf8_t p00, p01, p10, p11;
#pragma unroll
      for (int e = 0; e < 8; ++e) {
        p00[e] = (__bf16)s0[e]; p01[e] = (__bf16)s0[8 + e];
        p10[e] = (__bf16)s1[e]; p11[e] = (__bf16)s1[8 + e];
      }
      const bf8_t v000 = *(const bf8_t*)(Vc);
      const bf8_t v001 = *(const bf8_t*)(Vc + 16);
      const bf8_t v010 = *(const bf8_t*)(Vc + 32);
      const bf8_t v011 = *(const bf8_t*)(Vc + 48);
      const bf8_t v100 = *(const bf8_t*)(Vc + 32 * VLD);
      const bf8_t v101 = *(const bf8_t*)(Vc + 32 * VLD + 16);
      const bf8_t v110 = *(const bf8_t*)(Vc + 32 * VLD + 32);
      const bf8_t v111 = *(const bf8_t*)(Vc + 32 * VLD + 48);
      o0 = __builtin_amdgcn_mfma_f32_32x32x16_bf16(v000, p00, o0, 0, 0, 0);
      o1 = __builtin_amdgcn_mfma_f32_32x32x16_bf16(v100, p00, o1, 0, 0, 0);
      o0 = __builtin_amdgcn_mfma_f32_32x32x16_bf16(v001, p01, o0, 0, 0, 0);
      o1 = __builtin_amdgcn_mfma_f32_32x32x16_bf16(v101, p01, o1, 0, 0, 0);
      o0 = __builtin_amdgcn_mfma_f32_32x32x16_bf16(v010, p10, o0, 0, 0, 0);
      o1 = __builtin_amdgcn_mfma_f32_32x32x16_bf16(v110, p10, o1, 0, 0, 0);
      o0 = __builtin_amdgcn_mfma_f32_32x32x16_bf16(v011, p11, o0, 0, 0, 0);
      o1 = __builtin_amdgcn_mfma_f32_32x32x16_bf16(v111, p11, o1, 0, 0, 0);
    }
    __builtin_amdgcn_sched_barrier(0);
    if (kt + 1 < a.kt1) ATT_STORE(cur ^ 1);
    __syncthreads();
  }
#undef ATT_LOAD
#undef ATT_STORE
  l += __shfl_xor(l, 32);
  const float inv = 1.0f / l;
  const unsigned gq = (unsigned)(a.gt_base + a.qlt);
  const bf16_t* gp = (const bf16_t*)(ws + a.gate + gq * 2048u) + (lane >> 5) * 4;
  bf16_t* op = (bf16_t*)(const_cast<char*>(ws) + a.out + gq * 2048u) + (lane >> 5) * 4;
#pragma unroll
  for (int q = 0; q < 4; ++q) {
    const uint2 g0 = *(const uint2*)(gp + 8 * q);
    const uint2 g1 = *(const uint2*)(gp + 32 + 8 * q);
    *(uint2*)(op + 8 * q) = pack4(o0[4 * q] * inv * silu_fast(bf2f((bf16_t)(g0.x & 0xffff))),
                                  o0[4 * q + 1] * inv * silu_fast(bf2f((bf16_t)(g0.x >> 16))),
                                  o0[4 * q + 2] * inv * silu_fast(bf2f((bf16_t)(g0.y & 0xffff))),
                                  o0[4 * q + 3] * inv * silu_fast(bf2f((bf16_t)(g0.y >> 16))));
    *(uint2*)(op + 32 + 8 * q) = pack4(o1[4 * q] * inv * silu_fast(bf2f((bf16_t)(g1.x & 0xffff))),
                                       o1[4 * q + 1] * inv * silu_fast(bf2f((bf16_t)(g1.x >> 16))),
                                       o1[4 * q + 2] * inv * silu_fast(bf2f((bf16_t)(g1.y & 0xffff))),
                                       o1[4 * q + 3] * inv * silu_fast(bf2f((bf16_t)(g1.y >> 16))));
  }
}

template <int ABL>
__device__ void attention_phase(const Params& p_, char* smem, int wv) {
  const Params p = phase_params(p_);
  const int tid = opaque_tid(wv);
  const int lane = tid & 63, w = tid >> 6;
  constexpr int U_ML = NB * 8 * (SEQ / 128), U_GL = NB * 2 * (SEQ / 32);
  constexpr int U_MC = NB * 8 * (CTX / 128), U_GC = NB * 2 * (CTX / 32);
  constexpr int KT_ALL = NT / 64, KT_LAT = SEQ / 64;
  for (int u = blockIdx.x; u < U_ML + U_GL + U_MC + U_GC; u += gridDim.x) {
    AttnUnit a;
    a.tid = tid;
    a.kt1 = KT_ALL;
    if (u < U_ML || (u >= U_ML + U_GL && u < U_ML + U_GL + U_MC)) {
      const bool ctxq = u >= U_ML;
      const int v = ctxq ? u - (U_ML + U_GL) : u;
      const int nqb = ctxq ? CTX / 128 : SEQ / 128;
      const int qb = v % nqb, h = (v / nqb) & 7, b = v / (nqb * 8);
      a.q0 = (unsigned)WsOff::QN + h * 128; a.q0rb = 1024; a.q1 = (unsigned)WsOff::QR + h * 64; a.q1rb = 512;
      a.k0 = (unsigned)WsOff::KN + h * 128; a.k0rb = 1024; a.k1 = (unsigned)WsOff::KRb; a.k1rb = 64;
      a.vt = (unsigned)WsOff::VTA + (unsigned)((b * 8 + h) * 64) * (NT * 2);
      a.gt_base = b * NT;
      a.kt0 = ctxq ? KT_LAT : 0;
      a.qlt = (ctxq ? SEQ : 0) + qb * 128 + w * 32 + (lane & 31);
      a.gate = (unsigned)WsOff::GAB + h * 128; a.out = (unsigned)(ABL ? WsOff::H : WsOff::mixh) + h * 128;
      if (ABL != 6) attention_unit<96>(a, p.ws, smem);
    } else {
      const bool ctxq = u >= U_ML + U_GL;
      const int v = ctxq ? u - (U_ML + U_GL + U_MC) : u - U_ML;
      const int nqb = ctxq ? CTX / 32 : SEQ / 32;
      const int qb = v % nqb, kvh = (v / nqb) & 1, b = v / (nqb * 2);
      const int hq = kvh * 4 + w;
      a.q0 = (unsigned)WsOff::QG + hq * 128; a.q0rb = 1024; a.q1 = a.q0; a.q1rb = 1024;
      a.k0 = (unsigned)WsOff::KG + kvh * 128; a.k0rb = 256; a.k1 = a.k0; a.k1rb = 256;
      a.vt = (unsigned)WsOff::VTG + (unsigned)((b * 2 + kvh) * 64) * (NT * 2);
      a.gt_base = b * NT;
      a.kt0 = ctxq ? KT_LAT : 0;
      a.qlt = (ctxq ? SEQ : 0) + qb * 32 + (lane & 31);
      a.gate = (unsigned)WsOff::GAB + 1024 + hq * 128; a.out = (unsigned)(ABL ? WsOff::H : WsOff::mixh) + 1024 + hq * 128;
      if (ABL != 5) attention_unit<64>(a, p.ws, smem);
    }
  }
}

template <bool DUMMY>
__device__ void outproj_phase(const Params& p_, int layer, char* smem, int wv) {
  const Params p = phase_params(p_);
  const int tid = opaque_tid(wv);
  const int lane = tid & 63, w = tid >> 6, wr = w >> 1, wc = w & 1;
  const bf16_t* Wt = ((bf16_t*)(p.ws + WsOff::WtIn));
  const bool last = layer == 3;
  constexpr int NTL = D / 128;
  const int mtiles = NALL / 128;
  for (TileWalk tw(mtiles, NTL); tw.valid(); tw.next()) {
    const int mt = tw.mt(), nt = tw.nt();
    const int b = (mt * 128) / NT;
    const int ltile = mt * 128 - b * NT;
    const bool lat = ltile < SEQ;
    if (last && !lat) continue;
    f32x16 acc[2][2];
    gemm_tile_core(((bf16_t*)(p.ws + WsOff::mixh)), D, Wt, D, D, mt * 128, nt * 128, smem, true, acc, tid);
    const float* xin = lat ? (layer == 0 ? p.x + 0 : p.out + 0) + ((size_t)b * SEQ + ltile) * D
                           : (layer == 0 ? p.ctx + 0 : ((float*)(p.ws + WsOff::Xctx)) + 0) + ((size_t)b * CTX + (ltile - SEQ)) * D;
    float* xout = DUMMY ? (float*)((bf16_t*)(p.ws + WsOff::CQ)) + (size_t)(mt * 128) * D
                        : (lat ? p.out + ((size_t)b * SEQ + ltile) * D : ((float*)(p.ws + WsOff::Xctx)) + ((size_t)b * CTX + (ltile - SEQ)) * D);
    const int c0 = nt * 128 + wc * 64 + (lane >> 5) * 4;
    const float* gate = ((float*)(p.ws + WsOff::modv)) + ((size_t)layer * MODROWS + (lat ? b : NB)) * 3072 + 2048 + c0;
    const float* lg = p.ln_g + (layer > 0 ? layer - 1 : 0) * D + c0;
    const float* lb = p.ln_b + (layer > 0 ? layer - 1 : 0) * D + c0;
#pragma unroll
    for (int j = 0; j < 2; ++j) {
      const int rloc = wr * 64 + j * 32 + (lane & 31);
      const size_t ro = (size_t)rloc * D + c0;
      float mu = 0.f, rstd = 1.0f;
      if (layer > 0) { const float2 st = *(const float2*)(((float*)(p.ws + WsOff::LNS)) + (size_t)(mt * 128 + rloc) * 2); mu = st.x; rstd = st.y; }
#pragma unroll
      for (int i = 0; i < 2; ++i)
#pragma unroll
        for (int q = 0; q < 4; ++q) {
          float4 xv = *(const float4*)(xin + ro + 32 * i + 8 * q);
          if (layer > 0) {
            const float4 g4 = *(const float4*)(lg + 32 * i + 8 * q);
            const float4 b4 = *(const float4*)(lb + 32 * i + 8 * q);
            xv.x = (xv.x - mu) * rstd * g4.x + b4.x; xv.y = (xv.y - mu) * rstd * g4.y + b4.y;
            xv.z = (xv.z - mu) * rstd * g4.z + b4.z; xv.w = (xv.w - mu) * rstd * g4.w + b4.w;
          }
          const float4 gv = *(const float4*)(gate + 32 * i + 8 * q);
          float4 o;
          o.x = DN_ALPHA * xv.x + gv.x * acc[i][j][4 * q];
          o.y = DN_ALPHA * xv.y + gv.y * acc[i][j][4 * q + 1];
          o.z = DN_ALPHA * xv.z + gv.z * acc[i][j][4 * q + 2];
          o.w = DN_ALPHA * xv.w + gv.w * acc[i][j][4 * q + 3];
          *(float4*)(xout + ro + 32 * i + 8 * q) = o;
        }
    }
  }
}

template <bool DUMMY>
__device__ void ln_phase(const Params& p_, int layer, int wv) {
  const Params p = phase_params(p_);
  const int tid = opaque_tid(wv);
  const int lane = tid & 63;
  const int gw = (blockIdx.x * blockDim.x + tid) >> 6;
  const int nw = (gridDim.x * blockDim.x) >> 6;
  const bool last = layer == 3;
  const float* g = p.ln_g + layer * D;
  const float* bb = p.ln_b + layer * D;
  for (int gt = gw; gt < NALL; gt += nw) {
    const int b = gt / NT, lt = gt - b * NT;
    const bool lat = lt < SEQ;
    if (last && !lat) continue;
    float* xr = lat ? p.out + ((size_t)b * SEQ + lt) * D : ((float*)(p.ws + WsOff::Xctx)) + ((size_t)b * CTX + (lt - SEQ)) * D;
    float4 v[4];
    float s = 0.f;
#pragma unroll
    for (int k = 0; k < 4; ++k) {
      v[k] = *(const float4*)(xr + k * 256 + lane * 4);
      s += v[k].x + v[k].y + v[k].z + v[k].w;
    }
#pragma unroll
    for (int o = 32; o > 0; o >>= 1) s += __shfl_xor(s, o);
    const float mu = s * (1.0f / D);
    float q = 0.f;
#pragma unroll
    for (int k = 0; k < 4; ++k) {
      v[k].x -= mu; v[k].y -= mu; v[k].z -= mu; v[k].w -= mu;
      q += v[k].x * v[k].x + v[k].y * v[k].y + v[k].z * v[k].z + v[k].w * v[k].w;
    }
#pragma unroll
    for (int o = 32; o > 0; o >>= 1) q += __shfl_xor(q, o);
    const float rstd = rsqrtf(q * (1.0f / D) + EPS);
    if (!DUMMY && lane == 0) *(float2*)(((float*)(p.ws + WsOff::LNS)) + (size_t)gt * 2) = make_float2(mu, rstd);
    const float* modn = last ? nullptr : ((float*)(p.ws + WsOff::modv)) + ((size_t)(layer + 1) * MODROWS + (lat ? b : NB)) * 3072;
#pragma unroll
    for (int k = 0; k < 4; ++k) {
      const int c = k * 256 + lane * 4;
      const float4 gg = *(const float4*)(g + c);
      const float4 be = *(const float4*)(bb + c);
      float4 o;
      o.x = v[k].x * rstd * gg.x + be.x; o.y = v[k].y * rstd * gg.y + be.y;
      o.z = v[k].z * rstd * gg.z + be.z; o.w = v[k].w * rstd * gg.w + be.w;
      if (last) *(float4*)((DUMMY ? (float*)((bf16_t*)(p.ws + WsOff::CQ)) + (size_t)gt * D : xr) + c) = o;
      if (!last) {
        const float4 sh = *(const float4*)(modn + c);
        const float4 sc = *(const float4*)(modn + 1024 + c);
        *(uint2*)((DUMMY ? ((bf16_t*)(p.ws + WsOff::QN)) : ((bf16_t*)(p.ws + WsOff::H))) + (size_t)gt * D + c) = pack4(o.x * (1.0f + sc.x) + sh.x, o.y * (1.0f + sc.y) + sh.y,
                                                    o.z * (1.0f + sc.z) + sh.z, o.w * (1.0f + sc.w) + sh.w);
      }
    }
  }
}


__device__ __forceinline__ float sigmoid_fast(float x) { return 1.0f / (1.0f + __expf(-x)); }

__device__ void rec_inproj_phase(const Params& p_, char* smem, int wv) {
  const Params p = phase_params(p_);
  const int tid = opaque_tid(wv);
  const int lane = tid & 63, w = tid >> 6, wr = w >> 1, wc = w & 1;
  constexpr int MT = NALL / 128, NTL = REC_NPAD / 128;
  for (TileWalk tw(MT, NTL); tw.valid(); tw.next()) {
    const int mt = tw.mt(), nt = tw.nt();
    const int slab = 2 * nt + wc;
    f32x16 acc[2][2];
#ifndef REP_CORE
#define REP_CORE 1
#endif
    for (int rc = 0; rc < REP_CORE; ++rc) gemm_tile_core(((bf16_t*)(p.ws + WsOff::H)), D, ((bf16_t*)(p.ws + WsOff::WtIn)), D, D, mt * 128, nt * 128, smem, false, acc, tid);
    const int mbase = mt * 128 + wr * 64;
    if (slab < 48) {
      bf16_t* dst; int ld;
      if (slab < 24) { dst = ((bf16_t*)(p.ws + WsOff::PQKV)) + slab * 64; ld = 1536; }
      else if (slab < 40) { dst = ((bf16_t*)(p.ws + WsOff::PZG)) + (slab - 24) * 64; ld = 1024; }
      else { dst = ((bf16_t*)(p.ws + WsOff::PXR)) + (slab - 40) * 64; ld = 512; }
#pragma unroll
      for (int i = 0; i < 2; ++i)
#pragma unroll
        for (int j = 0; j < 2; ++j)
#pragma unroll
          for (int r = 0; r < 16; ++r) {
            const int gt = mbase + i * 32 + acc_row(r, lane);
            dst[(size_t)gt * ld + j * 32 + (lane & 31)] = f2bf_dev(acc[i][j][r]);
          }
    } else if (slab == 48) {
      if ((lane & 31) < 16) {
#pragma unroll
        for (int i = 0; i < 2; ++i)
#pragma unroll
          for (int r = 0; r < 16; ++r) {
            const int gt = mbase + i * 32 + acc_row(r, lane);
            ((float*)(p.ws + WsOff::PBA))[(size_t)gt * 16 + (lane & 31)] = acc[i][0][r];
          }
      }
    }
  }
}

template <int I>
struct FwdSub {
  static __device__ __forceinline__ void run(const float* M, float (&t)[64], int c) {
    FwdSub<I - 1>::run(M, t, c);
    float a0 = (I == c) ? 1.0f : 0.0f, a1 = 0.f, a2 = 0.f, a3 = 0.f;
    const float* row = M + I * 64;
#pragma unroll
    for (int j4 = 0; j4 < (I + 3) / 4; ++j4) {
      const float4 m = *(const float4*)(row + 4 * j4);
      if (4 * j4 + 0 < I) a0 -= m.x * t[4 * j4 + 0];
      if (4 * j4 + 1 < I) a1 -= m.y * t[4 * j4 + 1];
      if (4 * j4 + 2 < I) a2 -= m.z * t[4 * j4 + 2];
      if (4 * j4 + 3 < I) a3 -= m.w * t[4 * j4 + 3];
    }
    t[I] = (a0 + a1) + (a2 + a3);
  }
};
template <>
struct FwdSub<-1> {
  static __device__ __forceinline__ void run(const float*, float (&)[64], int) {}
};

__device__ void gdn_chunk_unit(const Params& p, int li, int b, int c, int h, char* smem, int wv) {
  const int tid = opaque_tid(wv);
  constexpr int QLD = 136;
  bf16_t* Qs = (bf16_t*)smem;
  bf16_t* Ks = Qs + 64 * QLD;
  float* M0 = (float*)smem;
  float* G = (float*)(smem + 2 * 64 * QLD * 2);
  float* gcs = G + 2 * 64 * 65;
  float* betas = gcs + 128;
  const int lane = tid & 63, w = tid >> 6;
  const int lt0 = c * 64;
  const bool lat = c < NCH_LAT;
  const int s0 = lat ? 0 : SEQ, s1 = lat ? SEQ : NT;
  const size_t gbase = (size_t)b * NT;
  {
    float* cws = G;
    const float* cw = p.gdn_conv_w + (size_t)li * 4 * 1536;
#pragma unroll
    for (int k = 0; k < 6; ++k) {
      const int i = tid + 256 * k;
      const int j = i / 384, c = i - j * 384;
      cws[i] = cw[(size_t)j * 1536 + (c >> 7) * 512 + h * 128 + (c & 127)];
    }
    __syncthreads();
    const int r = tid >> 2, cg = tid & 3;
    const int lt = lt0 + r;
    float tm[4];
    size_t rowoff[4];
#pragma unroll
    for (int j = 0; j < 4; ++j) {
      const int ltj = lt - 1 + j;
      tm[j] = (ltj >= s0 && ltj < s1) ? 1.0f : 0.0f;
      const int ltc = ltj < s0 ? s0 : (ltj >= s1 ? s1 - 1 : ltj);
      rowoff[j] = (gbase + ltc) * 1536;
    }
#pragma unroll 1
    for (int part = 0; part < 3; ++part) {
      const int col0 = part * 512 + h * 128 + cg * 32;
      uint4 xv[4][4];
#pragma unroll
      for (int j = 0; j < 4; ++j)
#pragma unroll
        for (int sub = 0; sub < 4; ++sub) xv[j][sub] = *(const uint4*)(((bf16_t*)(p.ws + WsOff::PQKV)) + rowoff[j] + col0 + sub * 8);
      float vals[32];
#pragma unroll
      for (int sub = 0; sub < 4; ++sub) {
        float y[8];
#pragma unroll
        for (int e = 0; e < 8; ++e) y[e] = 0.f;
#pragma unroll
        for (int j = 0; j < 4; ++j) {
          const float* wj = cws + j * 384 + part * 128 + cg * 32 + sub * 8;
          const float4 w0 = *(const float4*)wj;
          const float4 w1 = *(const float4*)(wj + 4);
          const uint4 x = xv[j][sub];
          const float mj = tm[j];
          y[0] += w0.x * mj * bf2f((bf16_t)(x.x & 0xffff)); y[1] += w0.y * mj * bf2f((bf16_t)(x.x >> 16));
          y[2] += w0.z * mj * bf2f((bf16_t)(x.y & 0xffff)); y[3] += w0.w * mj * bf2f((bf16_t)(x.y >> 16));
          y[4] += w1.x * mj * bf2f((bf16_t)(x.z & 0xffff)); y[5] += w1.y * mj * bf2f((bf16_t)(x.z >> 16));
          y[6] += w1.z * mj * bf2f((bf16_t)(x.w & 0xffff)); y[7] += w1.w * mj * bf2f((bf16_t)(x.w >> 16));
        }
#pragma unroll
        for (int e = 0; e < 8; ++e) vals[sub * 8 + e] = silu_fast(y[e]);
      }
      float sc = 1.0f;
      if (part < 2) {
        float ss = 0.f;
#pragma unroll
        for (int e = 0; e < 32; ++e) ss += vals[e] * vals[e];
        ss += __shfl_xor(ss, 1);
        ss += __shfl_xor(ss, 2);
        sc = rsqrtf(ss + EPS);
        if (part == 0) sc *= 0.08838834764831845f;
      }
      bf16_t* gdst = ((bf16_t*)(p.ws + WsOff::GQ)) + (size_t)part * NALL * 512 + (gbase + lt) * 512 + h * 128 + cg * 32;
      bf16_t* ldst = (part == 0 ? Qs : Ks) + r * QLD + cg * 32;
#pragma unroll
      for (int q = 0; q < 8; ++q) {
        const uint2 pk = pack4(vals[4 * q] * sc, vals[4 * q + 1] * sc, vals[4 * q + 2] * sc, vals[4 * q + 3] * sc);
        *(uint2*)(gdst + 4 * q) = pk;
        if (part < 2) *(uint2*)(ldst + 4 * q) = pk;
      }
    }
  }
  __syncthreads();
  {
    const int mat = w >> 1, i = w & 1;
    const bf16_t* Xs = (mat ? Qs : Ks) + (32 * i + (lane & 31)) * QLD + (lane >> 5) * 8;
    const bf16_t* Ys = Ks + (lane & 31) * QLD + (lane >> 5) * 8;
    f32x16 a0, a1;
#pragma unroll
    for (int r = 0; r < 16; ++r) { a0[r] = 0.f; a1[r] = 0.f; }
#pragma unroll
    for (int ks = 0; ks < 8; ++ks) {
      const bf8_t x = *(const bf8_t*)(Xs + ks * 16);
      const bf8_t y0 = *(const bf8_t*)(Ys + ks * 16);
      const bf8_t y1 = *(const bf8_t*)(Ys + 32 * QLD + ks * 16);
      a0 = __builtin_amdgcn_mfma_f32_32x32x16_bf16(x, y0, a0, 0, 0, 0);
      a1 = __builtin_amdgcn_mfma_f32_32x32x16_bf16(x, y1, a1, 0, 0, 0);
    }
    float* Gm = G + mat * 64 * 65;
#pragma unroll
    for (int r = 0; r < 16; ++r) {
      const int row = 32 * i + acc_row(r, lane);
      Gm[row * 65 + (lane & 31)] = a0[r];
      Gm[row * 65 + 32 + (lane & 31)] = a1[r];
    }
  }
  if (w < 2) {
    const int d = w, pos = lane;
    const int lt = d == 0 ? lt0 + pos : lt0 + 63 - pos;
    const float* ba = ((float*)(p.ws + WsOff::PBA)) + (gbase + lt) * 16;
    const float beta = sigmoid_fast(ba[d * 4 + h]);
    const float x = ba[8 + d * 4 + h] + p.gdn_dt_bias[li * 8 + d * 4 + h];
    const float sp = x > 20.0f ? x : log1pf(__expf(x));
    float g = -__expf(p.gdn_a_log[li * 8 + d * 4 + h]) * sp;
#pragma unroll
    for (int o = 1; o < 64; o <<= 1) {
      const float t = __shfl_up(g, o);
      if (lane >= o) g += t;
    }
    gcs[d * 64 + pos] = g;
    betas[d * 64 + pos] = beta;
    float* gcb = ((float*)(p.ws + WsOff::GCB)) + ((((size_t)b * 2 + d) * 4 + h) * NT + lt0 + pos) * 2;
    gcb[0] = g; gcb[1] = beta;
  }
  __syncthreads();
  {
    const size_t unit = ((size_t)b * NCH + c) * 4 + h;
#pragma unroll
    for (int d = 0; d < 2; ++d) {
      float* Md = M0 + d * 4096;
      bf16_t* at = ((bf16_t*)(p.ws + WsOff::ATTG)) + (unit * 2 + d) * 4096;
#pragma unroll 4
      for (int e = 0; e < 16; ++e) {
        const int idx = tid + 256 * e;
        const int i = idx >> 6, j = idx & 63;
        const int ti = d ? 63 - i : i, tj = d ? 63 - j : j;
        const float dec = i >= j ? __expf(gcs[d * 64 + i] - gcs[d * 64 + j]) : 0.f;
        Md[idx] = i > j ? betas[d * 64 + i] * G[ti * 65 + tj] * dec : 0.f;
        at[idx] = f2bf_dev(G[64 * 65 + ti * 65 + tj] * dec);
      }
    }
  }
  __syncthreads();
  if (w < 2) {
    const int d = w;
    typedef float f32x2 __attribute__((ext_vector_type(2)));
    const float* Mi = M0 + d * 4096;
    f32x2 tp[32];
#pragma unroll
    for (int k = 0; k < 32; ++k) tp[k] = (f32x2){0.f, 0.f};
#pragma unroll
    for (int I = 0; I < 64; ++I) {
      f32x2 aA = {0.f, 0.f}, aB = {0.f, 0.f};
#pragma unroll
      for (int j4 = 0; j4 < (I + 3) / 4; ++j4) {
        const float4 m = *(const float4*)(Mi + I * 64 + 4 * j4);
        aA = (f32x2){m.x, m.y} * tp[2 * j4] + aA;
        aB = (f32x2){m.z, m.w} * tp[2 * j4 + 1] + aB;
      }
      const f32x2 s2 = aA + aB;
      tp[I >> 1][I & 1] = ((I == lane) ? 1.0f : 0.0f) - (s2.x + s2.y);
    }
    const size_t unit = ((size_t)b * NCH + c) * 4 + h;
    bf16_t* tg = ((bf16_t*)(p.ws + WsOff::TG)) + (unit * 2 + d) * 4096 + lane;
    const float bc = betas[d * 64 + lane];
#pragma unroll
    for (int i = 0; i < 64; ++i) tg[i * 64] = f2bf_dev(tp[i >> 1][i & 1] * bc);
  }
  __syncthreads();
}

constexpr int LRU_CW_OFF = 77824;
struct LruIn { uint4 a0, a1, a2, a3, b0, b1, b2, b3; };
struct LruW {
  bf8_t r00, r01, r02, r03, i00, i01, i02, i03;
  bf8_t r10, r11, r12, r13, i10, i11, i12, i13;
  float br0, bi0, nls0, br1, bi1, nls1;
};
__device__ __forceinline__ void lru_load_in(const Params& p, int b, int c, int nb, int tid, LruIn& in) {
  const int r = tid >> 2, cg = tid & 3;
  const bool lat = c < NCH_LAT;
  const int s0 = lat ? 0 : SEQ, s1 = lat ? SEQ : NT;
  const int lt = c * 64 + r;
  const bf16_t* base = ((bf16_t*)(p.ws + WsOff::PXR)) + (size_t)b * NT * 512 + nb * 64 + cg * 16;
#define LRU_LD(J_)                                                                                          \
  {                                                                                                         \
    const int ltj = lt - 1 + J_;                                                                            \
    const int ltc = ltj < s0 ? s0 : (ltj >= s1 ? s1 - 1 : ltj);                                             \
    const bf16_t* src = base + (size_t)ltc * 512;                                                           \
    in.a##J_ = *(const uint4*)src; in.b##J_ = *(const uint4*)(src + 8);                                     \
  }
  LRU_LD(0) LRU_LD(1) LRU_LD(2) LRU_LD(3)
#undef LRU_LD
}
__device__ __forceinline__ void lru_load_w(const Params& p, int li, int nb, int tid, LruW& W) {
  const int lane = tid & 63, j = (tid >> 6) & 1;
  const bf16_t* w0 = ((bf16_t*)(p.ws + WsOff::WG)) + ((((size_t)li * 2 + 0) * 2 + 0) * 8 + nb) * 4096 + (32 * j + (lane & 31)) * 64 + (lane >> 5) * 8;
  const bf16_t* w1 = w0 + (size_t)2 * 8 * 4096;
  W.r00 = *(const bf8_t*)(w0); W.r01 = *(const bf8_t*)(w0 + 16); W.r02 = *(const bf8_t*)(w0 + 32); W.r03 = *(const bf8_t*)(w0 + 48);
  W.i00 = *(const bf8_t*)(w0 + 8 * 4096); W.i01 = *(const bf8_t*)(w0 + 8 * 4096 + 16); W.i02 = *(const bf8_t*)(w0 + 8 * 4096 + 32); W.i03 = *(const bf8_t*)(w0 + 8 * 4096 + 48);
  W.r10 = *(const bf8_t*)(w1); W.r11 = *(const bf8_t*)(w1 + 16); W.r12 = *(const bf8_t*)(w1 + 32); W.r13 = *(const bf8_t*)(w1 + 48);
  W.i10 = *(const bf8_t*)(w1 + 8 * 4096); W.i11 = *(const bf8_t*)(w1 + 8 * 4096 + 16); W.i12 = *(const bf8_t*)(w1 + 8 * 4096 + 32); W.i13 = *(const bf8_t*)(w1 + 8 * 4096 + 48);
  const int gch = nb * 64 + 32 * j + (lane & 31);
  W.br0 = p.lru_gate_b[(((size_t)li * 2 + 0) * 2 + 0) * 512 + gch];
  W.bi0 = p.lru_gate_b[(((size_t)li * 2 + 0) * 2 + 1) * 512 + gch];
  W.br1 = p.lru_gate_b[(((size_t)li * 2 + 1) * 2 + 0) * 512 + gch];
  W.bi1 = p.lru_gate_b[(((size_t)li * 2 + 1) * 2 + 1) * 512 + gch];
  const float lam0 = p.lru_lambda[((size_t)li * 2 + 0) * 512 + gch];
  const float lam1 = p.lru_lambda[((size_t)li * 2 + 1) * 512 + gch];
  W.nls0 = lam0 < -20.0f ? -lam0 : log1pf(__expf(-lam0));
  W.nls1 = lam1 < -20.0f ? -lam1 : log1pf(__expf(-lam1));
}
__device__ __forceinline__ void lru_stage_cw(const Params& p, int li, int nb, char* smem, int tid) {
  float* cwl = (float*)(smem + LRU_CW_OFF);
  for (int i = tid; i < 320; i += 256)
    cwl[i] = i < 256 ? p.lru_conv_w[(size_t)li * 4 * 512 + (i >> 6) * 512 + nb * 64 + (i & 63)] : p.lru_conv_b[li * 512 + nb * 64 + (i - 256)];
}

template <bool FINAL, int D>
__device__ __forceinline__ void lru_dir(const Params& p, int b, int c, int nb, const LruW& W, float hin, char* smem, int tid) {
  float* xl = (float*)smem;
  bf16_t* xlb = (bf16_t*)(smem + 16384);
  float* Al = (float*)(smem + 16384 + 9216);
  float* Bl = Al + 4096;
  float* R = Bl + 4096;
  float* SEG = R + 4096;
  const int lane = tid & 63, w = tid >> 6;
  {
    const int i = w >> 1, j = w & 1;
    const bf16_t* Xs = xlb + (32 * i + (lane & 31)) * 72 + (lane >> 5) * 8;
    const bf8_t x0 = *(const bf8_t*)(Xs), x1 = *(const bf8_t*)(Xs + 16), x2 = *(const bf8_t*)(Xs + 32), x3 = *(const bf8_t*)(Xs + 48);
    f32x16 ar, ai;
#pragma unroll
    for (int r = 0; r < 16; ++r) { ar[r] = 0.f; ai[r] = 0.f; }
    ar = __builtin_amdgcn_mfma_f32_32x32x16_bf16(x0, D ? W.r10 : W.r00, ar, 0, 0, 0);
    ai = __builtin_amdgcn_mfma_f32_32x32x16_bf16(x0, D ? W.i10 : W.i00, ai, 0, 0, 0);
    ar = __builtin_amdgcn_mfma_f32_32x32x16_bf16(x1, D ? W.r11 : W.r01, ar, 0, 0, 0);
    ai = __builtin_amdgcn_mfma_f32_32x32x16_bf16(x1, D ? W.i11 : W.i01, ai, 0, 0, 0);
    ar = __builtin_amdgcn_mfma_f32_32x32x16_bf16(x2, D ? W.r12 : W.r02, ar, 0, 0, 0);
    ai = __builtin_amdgcn_mfma_f32_32x32x16_bf16(x2, D ? W.i12 : W.i02, ai, 0, 0, 0);
    ar = __builtin_amdgcn_mfma_f32_32x32x16_bf16(x3, D ? W.r13 : W.r03, ar, 0, 0, 0);
    ai = __builtin_amdgcn_mfma_f32_32x32x16_bf16(x3, D ? W.i13 : W.i03, ai, 0, 0, 0);
    const int ch = 32 * j + (lane & 31);
    const float br = D ? W.br1 : W.br0, bi = D ? W.bi1 : W.bi0, nls = D ? W.nls1 : W.nls0;
#pragma unroll
    for (int r = 0; r < 16; ++r) {
      const int tok = 32 * i + acc_row(r, lane);
      const float rg = sigmoid_fast(ar[r] + br), ig = sigmoid_fast(ai[r] + bi);
      const float a = __expf(-8.0f * rg * nls);
      Al[tok * 64 + ch] = a;
      Bl[tok * 64 + ch] = sqrtf(fmaxf(1.0f - a * a, 0.f)) * ig * xl[tok * 64 + ch];
    }
  }
  __syncthreads();
  {
    const int ch = tid & 63, seg = tid >> 6;
    float ap = 1.0f, hb = 0.f;
#pragma unroll
    for (int s = 0; s < 16; ++s) {
      const int st = 16 * seg + s;
      const int tok = D == 0 ? st : 63 - st;
      const float a = Al[tok * 64 + ch];
      hb = a * hb + Bl[tok * 64 + ch];
      ap *= a;
    }
    SEG[(seg * 64 + ch) * 2] = ap;
    SEG[(seg * 64 + ch) * 2 + 1] = hb;
    __syncthreads();
    if (!FINAL) {
      if (seg == 0) {
        const size_t cidx = (((size_t)b * 2 + D) * NCH + c) * 512 + nb * 64 + ch;
        float A = 1.0f, Bv = 0.f;
#pragma unroll
        for (int s2 = 0; s2 < 4; ++s2) {
          const float2 sg2 = *(const float2*)(SEG + (s2 * 64 + ch) * 2);
          Bv = sg2.x * Bv + sg2.y;
          A *= sg2.x;
        }
        *(float2*)(((float*)(p.ws + WsOff::LCAR)) + cidx * 2) = make_float2(A, Bv);
      }
    } else {
      float hcur = hin;
      for (int s2 = 0; s2 < seg; ++s2) hcur = SEG[(s2 * 64 + ch) * 2] * hcur + SEG[(s2 * 64 + ch) * 2 + 1];
#pragma unroll
      for (int s = 0; s < 16; ++s) {
        const int st = 16 * seg + s;
        const int tok = D == 0 ? st : 63 - st;
        hcur = Al[tok * 64 + ch] * hcur + Bl[tok * 64 + ch];
        if (D == 0) R[tok * 64 + ch] = hcur;
        else R[tok * 64 + ch] += hcur;
      }
    }
  }
  __syncthreads();
}

template <bool FINAL>
__device__ __forceinline__ void lru_chunk_unit(const Params& p, int b, int c, int nb, LruIn& in, bool has_next, int b2, int c2,
                                               const LruW& W, char* smem, int tid) {
  float* xl = (float*)smem;
  bf16_t* xlb = (bf16_t*)(smem + 16384);
  float* R = (float*)(smem + 16384 + 9216) + 2 * 4096;
  const float* cwl = (const float*)(smem + LRU_CW_OFF);
  const int lt0 = c * 64;
  const bool lat = c < NCH_LAT;
  const int s0 = lat ? 0 : SEQ, s1 = lat ? SEQ : NT;
  const size_t gbase = (size_t)b * NT;
  float hin0 = 0.f, hin1 = 0.f;
  if (FINAL) {
    const size_t cidx = (((size_t)b * 2) * NCH + c) * 512 + nb * 64 + (tid & 63);
    hin0 = ((float*)(p.ws + WsOff::LHIN))[cidx];
    hin1 = ((float*)(p.ws + WsOff::LHIN))[cidx + (size_t)NCH * 512];
  }
  {
    const int r = tid >> 2, cg = tid & 3;
    const int lt = lt0 + r;
    float y[16];
#pragma unroll
    for (int q = 0; q < 4; ++q) {
      const float4 bv = *(const float4*)(cwl + 256 + cg * 16 + 4 * q);
      y[4 * q] = bv.x; y[4 * q + 1] = bv.y; y[4 * q + 2] = bv.z; y[4 * q + 3] = bv.w;
    }
#define LRU_TAP(J_)                                                                                         \
  {                                                                                                         \
    const int ltj = lt - 1 + J_;                                                                            \
    const float mk = (ltj >= s0 && ltj < s1) ? 1.0f : 0.0f;                                                 \
    const uint4 x0 = in.a##J_, x1 = in.b##J_;                                                               \
    const float* wrow = cwl + J_ * 64 + cg * 16;                                                            \
    const float4 w0 = *(const float4*)(wrow), w1 = *(const float4*)(wrow + 4), w2 = *(const float4*)(wrow + 8),  \
                 w3 = *(const float4*)(wrow + 12);                                                          \
    y[0] += w0.x * mk * bf2f((bf16_t)(x0.x & 0xffff)); y[1] += w0.y * mk * bf2f((bf16_t)(x0.x >> 16));      \
    y[2] += w0.z * mk * bf2f((bf16_t)(x0.y & 0xffff)); y[3] += w0.w * mk * bf2f((bf16_t)(x0.y >> 16));      \
    y[4] += w1.x * mk * bf2f((bf16_t)(x0.z & 0xffff)); y[5] += w1.y * mk * bf2f((bf16_t)(x0.z >> 16));      \
    y[6] += w1.z * mk * bf2f((bf16_t)(x0.w & 0xffff)); y[7] += w1.w * mk * bf2f((bf16_t)(x0.w >> 16));      \
    y[8] += w2.x * mk * bf2f((bf16_t)(x1.x & 0xffff)); y[9] += w2.y * mk * bf2f((bf16_t)(x1.x >> 16));      \
    y[10] += w2.z * mk * bf2f((bf16_t)(x1.y & 0xffff)); y[11] += w2.w * mk * bf2f((bf16_t)(x1.y >> 16));    \
    y[12] += w3.x * mk * bf2f((bf16_t)(x1.z & 0xffff)); y[13] += w3.y * mk * bf2f((bf16_t)(x1.z >> 16));    \
    y[14] += w3.z * mk * bf2f((bf16_t)(x1.w & 0xffff)); y[15] += w3.w * mk * bf2f((bf16_t)(x1.w >> 16));    \
  }
    LRU_TAP(0) LRU_TAP(1) LRU_TAP(2) LRU_TAP(3)
#undef LRU_TAP
#pragma unroll
    for (int q = 0; q < 4; ++q) {
      *(float4*)(xl + r * 64 + cg * 16 + 4 * q) = make_float4(y[4 * q], y[4 * q + 1], y[4 * q + 2], y[4 * q + 3]);
      *(uint2*)(xlb + r * 72 + cg * 16 + 4 * q) = pack4(y[4 * q], y[4 * q + 1], y[4 * q + 2], y[4 * q + 3]);
    }
  }
  if (has_next) lru_load_in(p, b2, c2, nb, tid, in);
  asm volatile("" ::: "memory");
  __syncthreads();
  lru_dir<FINAL, 0>(p, b, c, nb, W, hin0, smem, tid);
  lru_dir<FINAL, 1>(p, b, c, nb, W, hin1, smem, tid);
  if (FINAL) {
    const int r = tid >> 2, cg = tid & 3;
    const size_t gt = gbase + lt0 + r;
    const bf16_t* gr = ((bf16_t*)(p.ws + WsOff::PZG)) + gt * 1024 + 512 + nb * 64 + cg * 16;
    bf16_t* dst = ((bf16_t*)(p.ws + WsOff::mixh)) + gt * 1024 + 512 + nb * 64 + cg * 16;
#pragma unroll
    for (int q = 0; q < 4; ++q) {
      const uint2 gv = *(const uint2*)(gr + 4 * q);
      const float4 rv = *(const float4*)(R + r * 64 + cg * 16 + 4 * q);
      *(uint2*)(dst + 4 * q) = pack4(rv.x * silu_fast(bf2f((bf16_t)(gv.x & 0xffff))), rv.y * silu_fast(bf2f((bf16_t)(gv.x >> 16))),
                                     rv.z * silu_fast(bf2f((bf16_t)(gv.y & 0xffff))), rv.w * silu_fast(bf2f((bf16_t)(gv.y >> 16))));
    }
    __syncthreads();
  }
}

constexpr int N_EDGE = 14;
constexpr int N_EARLY = (NCH - NCH_LAT) + 2 * N_EDGE;
constexpr int N_LATE = NCH - N_EARLY;
constexpr int SCAN_WAIT_STEP = (NCH - NCH_LAT) + N_EDGE;
__device__ __forceinline__ int early_chunk(int i) {
  if (i < NCH - NCH_LAT) return NCH_LAT + i;
  const int k = i - (NCH - NCH_LAT);
  return k < N_EDGE ? k : NCH_LAT - 2 * N_EDGE + k;
}
template <int SEL>
__device__ void rec_chunk_phase(const Params& p_, int li, char* smem, int wv) {
  const Params p = phase_params(p_);
  constexpr int U_E = NB * N_EARLY * 4;
  for (int u = blockIdx.x; u < U_E; u += gridDim.x) {
    const int h = u & 3, c = early_chunk((u >> 2) % N_EARLY), b = (u >> 2) / N_EARLY;
    gdn_chunk_unit(p, li, b, c, h, smem, wv);
  }
  convert_outproj(p, 2 * li + 1, smem, opaque_tid(wv));
}

__device__ __forceinline__ int scan_chunk(int d, int n) {
  constexpr int NCTX = NCH - NCH_LAT;
  if (n < NCTX) return d == 0 ? NCH_LAT + n : NCH - 1 - n;
  const int m = n - NCTX;
  return d == 0 ? m : NCH_LAT - 1 - m;
}

__device__ __forceinline__ bf8_t ld_split(const bf16_t* p) {
  const uint2 lo = *(const uint2*)p;
  const uint2 hi = *(const uint2*)(p + 8);
  uint4 v = make_uint4(lo.x, lo.y, hi.x, hi.y);
  return *(bf8_t*)&v;
}
__device__ __forceinline__ bf8_t acc_frag(const f32x16& a, int half) {
  bf8_t f;
#pragma unroll
  for (int e = 0; e < 8; ++e) f[e] = (__bf16)a[8 * half + e];
  return f;
}

typedef __attribute__((ext_vector_type(4))) short s4_t;
__device__ __forceinline__ bf8_t ld_tr_split(const bf16_t* p0, int ld) {
  typedef __attribute__((address_space(3))) s4_t* lds_s4p;
  const s4_t lo = __builtin_amdgcn_ds_read_tr16_b64_v4i16((lds_s4p)(p0));
  const s4_t hi = __builtin_amdgcn_ds_read_tr16_b64_v4i16((lds_s4p)(p0 + 8 * ld));
  bf8_t f;
  *(s4_t*)&f = lo;
  *((s4_t*)&f + 1) = hi;
  return f;
}

typedef __attribute__((ext_vector_type(4))) float f32x4;
__device__ __forceinline__ bf8_t ld_split16(const bf16_t* p) {
  const uint2 lo = *(const uint2*)p;
  const uint2 hi = *(const uint2*)(p + 16);
  uint4 v = make_uint4(lo.x, lo.y, hi.x, hi.y);
  return *(bf8_t*)&v;
}
__device__ __forceinline__ bf8_t ld_tr_split16(const bf16_t* p0, int ld) {
  typedef __attribute__((address_space(3))) s4_t* lds_s4p;
  const s4_t lo = __builtin_amdgcn_ds_read_tr16_b64_v4i16((lds_s4p)(p0));
  const s4_t hi = __builtin_amdgcn_ds_read_tr16_b64_v4i16((lds_s4p)(p0 + 16 * ld));
  bf8_t f;
  *(s4_t*)&f = lo;
  *((s4_t*)&f + 1) = hi;
  return f;
}
__device__ __forceinline__ bf8_t acc_frag16(const f32x4& t0, const f32x4& t1) {
  bf8_t f;
#pragma unroll
  for (int e = 0; e < 4; ++e) { f[e] = (__bf16)t0[e]; f[4 + e] = (__bf16)t1[e]; }
  return f;
}

__device__ void gdn_scan_block(const Params& p, int b, int d, int h, int hv, unsigned* late_cnt, int hot, char* smem, int tid) {
  constexpr int QLD = 136, TLD = 72;
  constexpr int KLD = 128;
  bf16_t* Ks = (bf16_t*)smem;
  bf16_t* Qs = Ks + 64 * KLD;
  bf16_t* Vs = Qs + 64 * QLD;
  bf16_t* Ts = Vs + 64 * TLD;
  bf16_t* As = Ts + 64 * TLD;
  float* egs = (float*)(As + 64 * TLD);
  float* dls = egs + 128;
  const int lane = tid & 63, w = tid >> 6;
  const int m15 = lane & 15, g4 = (lane >> 4) * 4;
  const char* const pGK = (const char*)(((bf16_t*)(p.ws + WsOff::GK)) + (size_t)b * NT * 512 + h * 128);
  const char* const pGQ = (const char*)(((bf16_t*)(p.ws + WsOff::GQ)) + (size_t)b * NT * 512 + h * 128);
  const char* const pGV = (const char*)(((bf16_t*)(p.ws + WsOff::GV)) + (size_t)b * NT * 512 + h * 128 + hv * 64);
  const char* const pTG = (const char*)(((bf16_t*)(p.ws + WsOff::TG)) + ((size_t)b * NCH * 4 + h) * 2 * 4096 + d * 4096);
  const char* const pAT = (const char*)(((bf16_t*)(p.ws + WsOff::ATTG)) + ((size_t)b * NCH * 4 + h) * 2 * 4096 + d * 4096);
  const char* const pGCB = (const char*)(((float*)(p.ws + WsOff::GCB)) + (((size_t)b * 2 + d) * 4 + h) * NT * 2);
  bf16_t* const pOD = hot ? ((bf16_t*)(p.ws + WsOff::PQKV)) + ((size_t)b * 2 + d) * NT * 512 + h * 128 + hv * 64
                          : (d == 0 ? ((bf16_t*)(p.ws + WsOff::mixh)) + (size_t)b * NT * 1024 + h * 128 + hv * 64 : ((bf16_t*)(p.ws + WsOff::OD1)) + (size_t)b * NT * 512 + h * 128 + hv * 64);
  const unsigned ods = (d == 0 && !hot) ? 1024u : 512u;
  const unsigned odl = (unsigned)(16 * w + m15);
  const unsigned krow = (unsigned)(tid >> 4), kpart = (unsigned)(tid & 15);
  const unsigned vrow = (unsigned)(tid >> 3), vpart = (unsigned)(tid & 7);
  const unsigned kperm = (kpart >> 2) * 32 + (kpart & 1) * 16 + ((kpart >> 1) & 1) * 4;
  const unsigned kswz = ((krow & 3) << 1) | ((krow >> 2) & 1);
  const unsigned kp0 = (4 * (kpart >> 2) + 2 * (kpart & 1)) ^ kswz;
  const unsigned koff0 = 8 * kp0 + 4 * ((kpart >> 1) & 1), koff1 = 8 * (kp0 ^ 1) + 4 * ((kpart >> 1) & 1);
  const unsigned vperm = (vpart >> 2) * 32 + (vpart & 1) * 16 + ((vpart >> 1) & 1) * 4;
  uint4 sk0, sk1, sk2, sk3, sq0, sq1, sq2, sq3, sv0, sv1, st0, st1, sa0, sa1, sg;
  sg = make_uint4(0, 0, 0, 0);
  float sgl = 0.f;
  f32x4 S[8];
#pragma unroll
  for (int t = 0; t < 8; ++t)
#pragma unroll
    for (int r = 0; r < 4; ++r) S[t][r] = 0.f;
#define SCAN_LD_KQ(K_)                                                                                      \
  {                                                                                                         \
    const unsigned row = krow + 16 * K_;                                                                    \
    const unsigned off = ((unsigned)(c_ * 64) + (d ? 63u - row : row)) * 1024u + kpart * 16u;               \
    sk##K_ = *(const uint4*)(pGK + off);                                                                    \
    sq##K_ = *(const uint4*)(pGQ + off);                                                                    \
  }
#define SCAN_LD_VTA(K_)                                                                                     \
  {                                                                                                         \
    const unsigned row = vrow + 32 * K_;                                                                    \
    sv##K_ = *(const uint4*)(pGV + ((unsigned)(c_ * 64) + (d ? 63u - row : row)) * 1024u + vpart * 16u);   \
    const unsigned off = (unsigned)c_ * (4u * 2u * 8192u) + row * 128u + vpart * 16u;                       \
    st##K_ = *(const uint4*)(pTG + off);                                                                    \
    sa##K_ = *(const uint4*)(pAT + off);                                                                    \
  }
#define SCAN_LOAD(N_)                                                                                       \
  {                                                                                                         \
    const int c_ = hot ? 0 : scan_chunk(d, (N_));                                                           \
    SCAN_LD_KQ(0) SCAN_LD_KQ(1) SCAN_LD_KQ(2) SCAN_LD_KQ(3) SCAN_LD_VTA(0) SCAN_LD_VTA(1)                   \
    if (tid < 32) {                                                                                         \
      sg = *(const uint4*)(pGCB + (unsigned)(c_ * 64) * 8u + (unsigned)tid * 16u);                          \
      sgl = *(const float*)(pGCB + (unsigned)(c_ * 64 + 63) * 8u);                                          \
    }                                                                                                       \
  }
#define SCAN_ST_KQ(K_)                                                                                      \
  {                                                                                                         \
    const unsigned o_ = (krow + 16 * K_) * QLD + kperm;                                                     \
    const unsigned ok_ = (krow + 16 * K_) * KLD;                                                            \
    *(uint2*)(Ks + ok_ + koff0) = make_uint2(sk##K_.x, sk##K_.y); *(uint2*)(Ks + ok_ + koff1) = make_uint2(sk##K_.z, sk##K_.w); \
    *(uint2*)(Qs + o_) = make_uint2(sq##K_.x, sq##K_.y); *(uint2*)(Qs + o_ + 8) = make_uint2(sq##K_.z, sq##K_.w); \
  }
#define SCAN_ST_VTA(K_)                                                                                     \
  {                                                                                                         \
    const unsigned o_ = (vrow + 32 * K_) * TLD + vpart * 8;                                                 \
    const unsigned op_ = (vrow + 32 * K_) * TLD + vperm;                                                    \
    *(uint4*)(Vs + o_) = sv##K_;                                                                            \
    *(uint2*)(Ts + op_) = make_uint2(st##K_.x, st##K_.y); *(uint2*)(Ts + op_ + 8) = make_uint2(st##K_.z, st##K_.w); \
    *(uint2*)(As + op_) = make_uint2(sa##K_.x, sa##K_.y); *(uint2*)(As + op_ + 8) = make_uint2(sa##K_.z, sa##K_.w); \
  }
#define SCAN_STORE()                                                                                        \
  {                                                                                                         \
    SCAN_ST_KQ(0) SCAN_ST_KQ(1) SCAN_ST_KQ(2) SCAN_ST_KQ(3) SCAN_ST_VTA(0) SCAN_ST_VTA(1)                   \
    if (tid < 32) {                                                                                         \
      const float g0_ = __uint_as_float(sg.x), g1_ = __uint_as_float(sg.z);                                 \
      *(float2*)(egs + tid * 2) = make_float2(__expf(g0_), __expf(g1_));                                    \
      *(float2*)(dls + tid * 2) = make_float2(__expf(sgl - g0_), __expf(sgl - g1_));                        \
      if (tid == 0) dls[64] = __expf(sgl);                                                                  \
    }                                                                                                       \
  }
  SCAN_LOAD(0);
  SCAN_STORE();
  __syncthreads();
  const int kflip = (m15 >> 1) & 1, klow = (lane >> 4) ^ (((m15 & 1) << 1) | ((m15 >> 2) & 1));
  const bf16_t* const KfrA = Ks + m15 * KLD + 8 * klow + 32 * kflip;
  const bf16_t* const KfrB = Ks + m15 * KLD + 8 * klow + 32 * (1 - kflip);
  const bf16_t* const Qfr = Qs + m15 * QLD + 2 * g4;
  const bf16_t* const Tfr = Ts + m15 * TLD + 2 * g4;
  const bf16_t* const Afr = As + m15 * TLD + 2 * g4;
  const int tq = m15 >> 2, tflip = (tq >> 1) & 1, tlow = (lane & 3) ^ (((tq & 1) << 1) | ((lane >> 4) & 1));
  const bf16_t* const KTA = Ks + (g4 + tq) * KLD + 8 * tlow + 32 * tflip;
  const bf16_t* const KTB = Ks + (g4 + tq) * KLD + 8 * tlow + 32 * (1 - tflip);
  const bf16_t* const Vfr = Vs + (g4 + (m15 >> 2)) * TLD + 16 * w + 4 * (lane & 3);
  typedef __attribute__((address_space(3))) s4_t* lds_s4p_t;
#define SB() __builtin_amdgcn_sched_barrier(0)
#define LDF4(F_, BASE_, LD_, KK_)                                                                           \
  {                                                                                                         \
    F_##0 = *(const bf8_t*)(BASE_ + 32 * (KK_));                                                            \
    F_##1 = *(const bf8_t*)(BASE_ + 16 * LD_ + 32 * (KK_));                                                 \
    F_##2 = *(const bf8_t*)(BASE_ + 32 * LD_ + 32 * (KK_));                                                 \
    F_##3 = *(const bf8_t*)(BASE_ + 48 * LD_ + 32 * (KK_));                                                 \
  }
#define MF4(A_, F_, B_)                                                                                     \
  {                                                                                                         \
    A_##0 = __builtin_amdgcn_mfma_f32_16x16x32_bf16(F_##0, B_, A_##0, 0, 0, 0);                             \
    A_##1 = __builtin_amdgcn_mfma_f32_16x16x32_bf16(F_##1, B_, A_##1, 0, 0, 0);                             \
    A_##2 = __builtin_amdgcn_mfma_f32_16x16x32_bf16(F_##2, B_, A_##2, 0, 0, 0);                             \
    A_##3 = __builtin_amdgcn_mfma_f32_16x16x32_bf16(F_##3, B_, A_##3, 0, 0, 0);                             \
    asm volatile("" : "+v"(A_##0), "+v"(A_##1), "+v"(A_##2), "+v"(A_##3));                                  \
  }
#define MF4S(A_, F_, K_)                                                                                    \
  {                                                                                                         \
    asm volatile("" : "+v"(S[2 * K_]), "+v"(S[2 * K_ + 1]));                                                \
    const bf8_t sb_ = acc_frag16(S[2 * K_], S[2 * K_ + 1]);                                                 \
    MF4(A_, F_, sb_)                                                                                        \
  }
#define LDKT(F_, T0_)                                                                                       \
  {                                                                                                         \
    const bf16_t* const kt_ = ((((T0_) >> 1) & 1) ? KTB : KTA) + 64 * ((T0_) >> 2);                         \
    F_##0 = ld_tr_split16(kt_, KLD);                                                                        \
    F_##1 = ld_tr_split16(kt_ + 32 * KLD, KLD);                                                             \
    F_##2 = ld_tr_split16(kt_ + 4, KLD);                                                                    \
    F_##3 = ld_tr_split16(kt_ + 32 * KLD + 4, KLD);                                                         \
  }
#define MFKT(F_, T0_)                                                                                       \
  {                                                                                                         \
    S[T0_] = __builtin_amdgcn_mfma_f32_16x16x32_bf16(F_##0, vk0, S[T0_], 0, 0, 0);                          \
    S[(T0_) + 1] = __builtin_amdgcn_mfma_f32_16x16x32_bf16(F_##2, vk0, S[(T0_) + 1], 0, 0, 0);              \
    S[T0_] = __builtin_amdgcn_mfma_f32_16x16x32_bf16(F_##1, vk1, S[T0_], 0, 0, 0);                          \
    S[(T0_) + 1] = __builtin_amdgcn_mfma_f32_16x16x32_bf16(F_##3, vk1, S[(T0_) + 1], 0, 0, 0);              \
    asm volatile("" : "+v"(S[T0_]), "+v"(S[(T0_) + 1]));                                                    \
  }
  for (int n = 0; n < NCH; ++n) {
    if (n + 1 == SCAN_WAIT_STEP && late_cnt) wait_ge(late_cnt, (unsigned)(NB * N_LATE * 4), tid);
    bf8_t fa0, fa1, fa2, fa3, fb0, fb1, fb2, fb3;
    LDF4(fa, KfrA, KLD, 0) LDF4(fb, KfrB, KLD, 0)
    SB();
    if (n + 1 < NCH && hot < 2) SCAN_LOAD(n + 1);
    asm volatile("" ::: "memory");
    SB();
    const int c = scan_chunk(d, n);
    f32x4 a0 = {0.f, 0.f, 0.f, 0.f}, a1 = a0, a2 = a0, a3 = a0;
    MF4S(a, fa, 0)
    SB();
    LDF4(fa, KfrA, KLD, 2)
    SB();
    MF4S(a, fb, 1)
    SB();
    LDF4(fb, KfrB, KLD, 2)
    SB();
    MF4S(a, fa, 2)
    SB();
    LDF4(fa, Tfr, TLD, 0)
    SB();
    MF4S(a, fb, 3)
    SB();
    {
      const f32x4 eg0 = *(const f32x4*)(egs + g4), eg1 = *(const f32x4*)(egs + 16 + g4), eg2 = *(const f32x4*)(egs + 32 + g4),
                  eg3 = *(const f32x4*)(egs + 48 + g4);
      const s4_t vv0 = __builtin_amdgcn_ds_read_tr16_b64_v4i16((lds_s4p_t)(Vfr)), vv1 = __builtin_amdgcn_ds_read_tr16_b64_v4i16((lds_s4p_t)(Vfr + 16 * TLD)),
                 vv2 = __builtin_amdgcn_ds_read_tr16_b64_v4i16((lds_s4p_t)(Vfr + 32 * TLD)), vv3 = __builtin_amdgcn_ds_read_tr16_b64_v4i16((lds_s4p_t)(Vfr + 48 * TLD));
      fb0 = *(const bf8_t*)(Tfr + 32 * TLD + 32); fb1 = *(const bf8_t*)(Tfr + 48 * TLD + 32);
      SB();
#define RT_EPI(I_)                                                                                          \
  _Pragma("unroll") for (int r = 0; r < 4; ++r)                                                             \
      a##I_[r] = bf2f((unsigned short)vv##I_[r]) - eg##I_[r] * a##I_[r];
      RT_EPI(0) RT_EPI(1) RT_EPI(2) RT_EPI(3)
#undef RT_EPI
    }
    const bf8_t rb0 = acc_frag16(a0, a1), rb1 = acc_frag16(a2, a3);
    f32x4 vn0 = {0.f, 0.f, 0.f, 0.f}, vn1 = vn0, vn2 = vn0, vn3 = vn0;
    MF4(vn, fa, rb0)
    SB();
    LDF4(fa, Qfr, QLD, 0)
    SB();
    vn2 = __builtin_amdgcn_mfma_f32_16x16x32_bf16(fb0, rb1, vn2, 0, 0, 0);
    vn3 = __builtin_amdgcn_mfma_f32_16x16x32_bf16(fb1, rb1, vn3, 0, 0, 0);
    asm volatile("" : "+v"(vn2), "+v"(vn3));
    SB();
    LDF4(fb, Qfr, QLD, 1)
    SB();
    f32x4 o0 = {0.f, 0.f, 0.f, 0.f}, o1 = o0, o2 = o0, o3 = o0;
    MF4S(o, fa, 0)
    SB();
    LDF4(fa, Qfr, QLD, 2)
    SB();
    MF4S(o, fb, 1)
    SB();
    LDF4(fb, Qfr, QLD, 3)
    SB();
    MF4S(o, fa, 2)
    SB();
    LDF4(fa, Afr, TLD, 0)
    const f32x4 eg0 = *(const f32x4*)(egs + g4), eg1 = *(const f32x4*)(egs + 16 + g4), eg2 = *(const f32x4*)(egs + 32 + g4),
                eg3 = *(const f32x4*)(egs + 48 + g4);
    SB();
    MF4S(o, fb, 3)
    SB();
    fb0 = *(const bf8_t*)(Afr + 32 * TLD + 32); fb1 = *(const bf8_t*)(Afr + 48 * TLD + 32);
    SB();
    {
      const bf8_t vb0 = acc_frag16(vn0, vn1), vb1 = acc_frag16(vn2, vn3);
#define O_SC(I_) _Pragma("unroll") for (int r = 0; r < 4; ++r) o##I_[r] *= eg##I_[r];
      O_SC(0) O_SC(1) O_SC(2) O_SC(3)
#undef O_SC
      MF4(o, fa, vb0)
      SB();
      LDKT(fa, 0)
      SB();
      o2 = __builtin_amdgcn_mfma_f32_16x16x32_bf16(fb0, vb1, o2, 0, 0, 0);
      o3 = __builtin_amdgcn_mfma_f32_16x16x32_bf16(fb1, vb1, o3, 0, 0, 0);
      asm volatile("" : "+v"(o2), "+v"(o3));
    }
    SB();
    LDKT(fb, 2)
    const f32x4 dl0 = *(const f32x4*)(dls + g4), dl1 = *(const f32x4*)(dls + 16 + g4), dl2 = *(const f32x4*)(dls + 32 + g4),
                dl3 = *(const f32x4*)(dls + 48 + g4);
    const float egl_all = dls[64];
    SB();
#define VN_SC(I_) _Pragma("unroll") for (int r = 0; r < 4; ++r) vn##I_[r] *= dl##I_[r];
    VN_SC(0) VN_SC(1) VN_SC(2) VN_SC(3)
#undef VN_SC
    const bf8_t vk0 = acc_frag16(vn0, vn1), vk1 = acc_frag16(vn2, vn3);
#pragma unroll
    for (int t = 0; t < 8; ++t)
#pragma unroll
      for (int r = 0; r < 4; ++r) S[t][r] *= egl_all;
    MFKT(fa, 0)
    SB();
    LDKT(fa, 4)
    SB();
#define O_ST(I_)                                                                                            \
  _Pragma("unroll") for (int r = 0; r < 4; ++r) {                                                           \
    const int pos = 16 * I_ + g4 + r;                                                                       \
    const int lt = c * 64 + (d ? 63 - pos : pos);                                                           \
    pOD[(unsigned)lt * ods + odl] = f2bf_dev(o##I_[r]);                                                     \
  }
    O_ST(0) O_ST(1) O_ST(2) O_ST(3)
#undef O_ST
    MFKT(fb, 2)
    SB();
    LDKT(fb, 6)
    SB();
    MFKT(fa, 4)
    SB();
    MFKT(fb, 6)
    SB();
    if (hot < 2) {
      asm volatile("s_waitcnt lgkmcnt(0)\n\ts_barrier" ::: "memory");
      if (n + 1 < NCH) SCAN_STORE();
      asm volatile("s_waitcnt lgkmcnt(0)\n\ts_barrier" ::: "memory");
    }
  }
#undef SB
#undef LDF4
#undef MF4
#undef LDKT
#undef MF4S
#undef MFKT
#undef SCAN_LOAD
#undef SCAN_STORE
#undef SCAN_LD_KQ
#undef SCAN_LD_VTA
#undef SCAN_ST_KQ
#undef SCAN_ST_VTA
}

__device__ void rec_scan_phase(const Params& p_, int li, int cslot, int MODE, char* smem, int wv) {
  const Params p = phase_params(p_);
  const int tid = opaque_tid(wv);
  constexpr int NGDN = NB * 2 * 4 * 2;
  constexpr int NLRU = NB * 2 * 512 / 256;
  constexpr int U_L = NB * NCH * 8;
  const int bid = blockIdx.x;
  if (bid < NGDN) {
    const int hv = bid & 1, h = (bid >> 1) & 3, d = (bid >> 3) & 1, b = bid >> 4;
    if (MODE < 2 || MODE == 3 || MODE == 7) gdn_scan_block(p, b, d, h, hv, MODE != 0 ? nullptr : ((unsigned*)(p.ws + WsOff::bar)) + 4 * cslot + 2, MODE == 3 ? 1 : (MODE == 7 ? 2 : 0), smem, tid);
    return;
  }
  if (MODE == 1 || MODE == 3 || MODE == 7) return;
  const int nw = (int)gridDim.x - NGDN, me = bid - NGDN;
  unsigned* cnt1 = ((unsigned*)(p.ws + WsOff::bar)) + 4 * cslot;
  unsigned* cnt2 = ((unsigned*)(p.ws + WsOff::bar)) + 4 * cslot + 1;
  if (MODE != 5 && MODE != 6) {
    constexpr int U_LATE = NB * N_LATE * 4;
    unsigned done = 0;
    for (int u = me; u < U_LATE; u += nw) {
      const int h = u & 3, c = N_EDGE + (u >> 2) % N_LATE, b = (u >> 2) / N_LATE;
      gdn_chunk_unit(p, li, b, c, h, smem, wv);
      ++done;
    }
    signal_add(((unsigned*)(p.ws + WsOff::bar)) + 4 * cslot + 2, done, tid);
  }
  if (MODE == 4) return;
  constexpr int NBC = NB * NCH;
  const int nwg = nw >> 3, nb = me & 7, grp = me >> 3;
  LruW W;
  LruIn in;
  if (grp < nwg) {
    lru_load_w(p, li, nb, tid, W);
    lru_stage_cw(p, li, nb, smem, tid);
    if (grp < NBC) lru_load_in(p, grp / NCH, grp % NCH, nb, tid, in);
    __syncthreads();
    unsigned done = 0;
    for (int k = grp; k < NBC; k += nwg) {
      const int k2 = k + nwg;
      lru_chunk_unit<false>(p, k / NCH, k % NCH, nb, in, k2 < NBC, k2 / NCH, k2 % NCH, W, smem, tid);
      ++done;
    }
    signal_add(cnt1, done, tid);
  }
  if (MODE == 5) return;
  if (me < NLRU) {
    wait_ge(cnt1, (unsigned)U_L, tid);
    const int chain = me * 256 + tid;
    const int ch = chain & 511, d = (chain >> 9) & 1, b = chain >> 10;
    float hcur = 0.f;
    const float2* car = (const float2*)((float*)(p.ws + WsOff::LCAR)) + ((size_t)b * 2 + d) * NCH * 512 + ch;
    float* hin = ((float*)(p.ws + WsOff::LHIN)) + ((size_t)b * 2 + d) * NCH * 512 + ch;
#pragma unroll 1
    for (int n0 = 0; n0 < NCH; n0 += 17) {
      float2 ab[17];
#pragma unroll
      for (int k = 0; k < 17; ++k) ab[k] = car[(size_t)scan_chunk(d, n0 + k) * 512];
#pragma unroll
      for (int k = 0; k < 17; ++k) {
        hin[(size_t)scan_chunk(d, n0 + k) * 512] = hcur;
        hcur = ab[k].x * hcur + ab[k].y;
      }
    }
    signal_add(cnt2, 1u, tid);
  }
  if (grp < nwg) {
    if (grp < NBC) lru_load_in(p, grp / NCH, grp % NCH, nb, tid, in);
    wait_ge(cnt2, (unsigned)NLRU, tid);
    for (int k = grp; k < NBC; k += nwg) {
      const int k2 = k + nwg;
      lru_chunk_unit<true>(p, k / NCH, k % NCH, nb, in, k2 < NBC, k2 / NCH, k2 % NCH, W, smem, tid);
    }
  }
}

__device__ void rec_mix_phase(const Params& p_, int li, char* smem, int wv) {
  const Params p = phase_params(p_);
  const int tid = opaque_tid(wv);
  {
    const long ngrp = (long)NALL * 4;
    const int sub = tid & 15;
    for (long g = ((long)blockIdx.x * 256 + tid) >> 4; g < ngrp; g += ((long)gridDim.x * 256) >> 4) {
      const size_t gt = (size_t)(g >> 2);
      const int h = (int)(g & 3);
      const uint4 o0 = *(const uint4*)(((bf16_t*)(p.ws + WsOff::mixh)) + gt * 1024 + h * 128 + sub * 8);
      const uint4 o1 = *(const uint4*)(((bf16_t*)(p.ws + WsOff::OD1)) + gt * 512 + h * 128 + sub * 8);
      const uint4 zv = *(const uint4*)(((bf16_t*)(p.ws + WsOff::PZG)) + gt * 1024 + h * 128 + sub * 8);
      float o[8];
      const unsigned* a0 = (const unsigned*)&o0; const unsigned* a1 = (const unsigned*)&o1;
#pragma unroll
      for (int e = 0; e < 4; ++e) {
        o[2 * e] = bf2f((bf16_t)(a0[e] & 0xffff)) + bf2f((bf16_t)(a1[e] & 0xffff));
        o[2 * e + 1] = bf2f((bf16_t)(a0[e] >> 16)) + bf2f((bf16_t)(a1[e] >> 16));
      }
      float ss = 0.f;
#pragma unroll
      for (int e = 0; e < 8; ++e) ss += o[e] * o[e];
      ss += __shfl_xor(ss, 1); ss += __shfl_xor(ss, 2); ss += __shfl_xor(ss, 4); ss += __shfl_xor(ss, 8);
      const float rinv = rsqrtf(ss * (1.0f / 128.0f) + EPS);
      const float* nw = p.gdn_norm + li * 128 + sub * 8;
      const unsigned* zz = (const unsigned*)&zv;
      float y[8];
#pragma unroll
      for (int e = 0; e < 4; ++e) {
        y[2 * e] = o[2 * e] * rinv * nw[2 * e] * silu_fast(bf2f((bf16_t)(zz[e] & 0xffff)));
        y[2 * e + 1] = o[2 * e + 1] * rinv * nw[2 * e + 1] * silu_fast(bf2f((bf16_t)(zz[e] >> 16)));
      }
      const uint2 lo = pack4(y[0], y[1], y[2], y[3]), hi = pack4(y[4], y[5], y[6], y[7]);
      *(uint4*)(((bf16_t*)(p.ws + WsOff::mixh)) + gt * 1024 + h * 128 + sub * 8) = make_uint4(lo.x, lo.y, hi.x, hi.y);
    }
  }
}
__device__ __forceinline__ void h0_vec(const float* src, const float* modrow, bf16_t* dst, int j) {
  const float4 x0 = *(const float4*)src, x1 = *(const float4*)(src + 4);
  const float4 h0 = *(const float4*)(modrow + j), h1 = *(const float4*)(modrow + j + 4);
  const float4 c0 = *(const float4*)(modrow + 1024 + j), c1 = *(const float4*)(modrow + 1024 + j + 4);
  const uint2 lo = pack4(x0.x * (1.0f + c0.x) + h0.x, x0.y * (1.0f + c0.y) + h0.y, x0.z * (1.0f + c0.z) + h0.z, x0.w * (1.0f + c0.w) + h0.w);
  const uint2 hi = pack4(x1.x * (1.0f + c1.x) + h1.x, x1.y * (1.0f + c1.y) + h1.y, x1.z * (1.0f + c1.z) + h1.z, x1.w * (1.0f + c1.w) + h1.w);
  *(uint4*)dst = make_uint4(lo.x, lo.y, hi.x, hi.y);
}
#define FOR_ITEMS(n) for (long i = (long)blockIdx.x * 256 + opaque_tid(wv), gstride_ = (long)gridDim.x * 256; i < (long)(n); i += gstride_)
#ifndef REP_ATTIN
#define REP_ATTIN 1
#endif
#ifndef REP_UP
#define REP_UP 1
#endif
#ifndef REP_ATT
#define REP_ATT 1
#endif
#ifndef REP_RECIN
#define REP_RECIN 1
#endif
#ifndef REP_CHUNK
#define REP_CHUNK 1
#endif
#ifndef REP_SCAN
#define REP_SCAN 1
#endif
#ifndef REP_MIX
#define REP_MIX 1
#endif
#ifndef REP_SYNC
#define REP_SYNC 1
#endif
#ifndef SCAN_MODE
#define SCAN_MODE 0
#endif
#define GSYNC() for (int rs_ = 0; rs_ < REP_SYNC; ++rs_) xcd_barrier(((unsigned*)(p.ws + WsOff::bar)), opaque_tid(wv))
__device__ __forceinline__ int convert_inproj(const Params& p, int layer, int u0, char* smem, int tid) {
  const int li2 = layer >> 1;
  const bool att = (layer & 1) == 0;
  const float* src = att ? p.att_w_in + (size_t)li2 * D * ATT_IN : p.rec_w_in + (size_t)li2 * D * REC_IN;
  return wconv_matrix(src, att ? ATT_IN : REC_IN, att ? ATT_NPAD : REC_NPAD, D, ((bf16_t*)(p.ws + WsOff::WtIn)), att ? 1 : 4, nullptr, u0, smem, tid);
}

__global__ void __launch_bounds__(256, 2) megakernel(Params p) {
  cg::grid_group grid = cg::this_grid();
  const int wv = wave_index();
  __shared__ __attribute__((aligned(16))) char smem[LDS_BYTES];
  if (opaque_tid(wv) == 0) { *(volatile unsigned*)(smem + XB_LDS_OFF) = 0u; *(volatile unsigned*)(smem + XB_LDS_OFF + 4) = 0u; }
  __syncthreads();
  xcd_barrier_post(((unsigned*)(p.ws + WsOff::bar)), opaque_tid(wv));
#ifndef REP_PRO
#define REP_PRO 1
#endif
  for (int rpp = 0; rpp < REP_PRO; ++rpp) {
  mod_phase(p, smem, opaque_tid(wv));
  {
    const int tid = opaque_tid(wv);
    int u0 = convert_inproj(p, 0, 0, smem, tid);
    for (int li3 = 0; li3 < 2; ++li3) {
      u0 = wconv_matrix(p.mla_w_uq + (size_t)li3 * 256 * 768, 768, 768, 256, ((bf16_t*)(p.ws + WsOff::Wuq)) + (size_t)li3 * 768 * 256, 2,
                        p.mla_q_norm + li3 * 256, u0, smem, tid);
      u0 = wconv_matrix(p.mla_w_ukv + (size_t)li3 * 128 * 1024, 1024, 1024, 128, ((bf16_t*)(p.ws + WsOff::Wukv)) + (size_t)li3 * 1024 * 128, 3,
                        p.mla_kv_norm + li3 * 128, u0, smem, tid);
    }
    for (int mat = blockIdx.x; mat < 64; mat += gridDim.x)
      wconv_tile(p.lru_gate_w + (size_t)mat * 4096, 64, 64, ((bf16_t*)(p.ws + WsOff::WG)) + (size_t)mat * 4096, 0, nullptr, 0, 0, smem, tid);
  }
  FOR_ITEMS(64 * 16 + 64 * 8) { rope_table_item(p, (int)i); }
  }
  GSYNC();
  FOR_ITEMS((long)NB * SEQ * (D / 8)) {
    const int j = (int)(i & 127) * 8; const long row = i >> 7; const int b = (int)(row / SEQ); const int t = (int)(row - (long)b * SEQ);
    h0_vec(p.x + row * D + j, ((float*)(p.ws + WsOff::modv)) + (size_t)b * 3072, ((bf16_t*)(p.ws + WsOff::H)) + ((size_t)b * NT + t) * D + j, j);
  }
  FOR_ITEMS((long)NB * CTX * (D / 8)) {
    const int j = (int)(i & 127) * 8; const long row = i >> 7; const int b = (int)(row / CTX); const int t = (int)(row - (long)b * CTX);
    h0_vec(p.ctx + row * D + j, ((float*)(p.ws + WsOff::modv)) + (size_t)NB * 3072, ((bf16_t*)(p.ws + WsOff::H)) + ((size_t)b * NT + SEQ + t) * D + j, j);
  }
  GSYNC();
  for (int layer = 0; layer < 4; ++layer) {
    const int li = layer >> 1;
    if ((layer & 1) == 0) {
      for (int rp = 0; rp < REP_ATTIN; ++rp) att_inproj_phase(p, layer, smem, wv);
      GSYNC();
      for (int rp = 0; rp < REP_UP; ++rp) upproj_phase(p, layer, smem, wv);
      GSYNC();
      for (int rp = 0; rp < REP_ATT; ++rp) attention_phase<0>(p, smem, wv);
#ifdef ATT_ABL
      attention_phase<ATT_ABL>(p, smem, wv);
#endif
      GSYNC();
    } else {
      for (int rp = 0; rp < REP_RECIN; ++rp) rec_inproj_phase(p, smem, wv);
      GSYNC();
      for (int rp = 0; rp < REP_CHUNK; ++rp) rec_chunk_phase<0>(p, li, smem, wv);
#ifdef CHUNK_SEL
      rec_chunk_phase<CHUNK_SEL>(p, li, smem, wv);
#endif
      GSYNC();
      for (int rp = 0; rp < REP_SCAN; ++rp) { rec_scan_phase(p, li, li + 2 * rp, rp == 0 ? 0 : SCAN_MODE, smem, wv); __syncthreads(); if (rp + 1 < REP_SCAN) GSYNC(); }
      if (layer == 1) grid.sync(); else GSYNC();
      for (int rp = 0; rp < REP_MIX; ++rp) rec_mix_phase(p, li, smem, wv);
      GSYNC();
    }
    outproj_phase<false>(p, layer, smem, wv);
#ifdef OUT_EXTRA
    outproj_phase<true>(p, layer, smem, wv);
#endif
    GSYNC();
#ifdef LN_EXTRA
    ln_phase<true>(p, layer, wv);
#endif
    ln_phase<false>(p, layer, wv);
    if (layer < 3) (void)convert_inproj(p, layer + 1, 0, smem, opaque_tid(wv));
    GSYNC();
  }
}

extern "C" void kernel_launch(void* const* d_in, const int* in_sizes, int n_in, void* d_out, int out_size,
                              void* d_ws, size_t ws_size, hipStream_t stream) {
  Params p{};
  const float** pp = (const float**)&p;
  for (int i = 0; i < 27; ++i) pp[i] = (const float*)d_in[i];
  p.out = (float*)d_out;
  p.ws = (char*)d_ws;
  const size_t need = WsOff::total;
  if (need > ws_size) { fprintf(stderr, "workspace too small: need %zu have %zu\n", need, ws_size); return; }
  static int grid_blocks = 0;
  if (!grid_blocks) {
    int dev = 0, cus = 0, per_cu = 0;
    (void)hipGetDevice(&dev);
    (void)hipDeviceGetAttribute(&cus, hipDeviceAttributeMultiprocessorCount, dev);
    (void)hipOccupancyMaxActiveBlocksPerMultiprocessor(&per_cu, megakernel, 256, 0);
    if (per_cu > 2) per_cu = 2;
    grid_blocks = cus * per_cu;
  }
  (void)hipMemsetAsync((char*)d_ws + WsOff::bar, 0, (size_t)XCD_BAR_WORDS * 4, stream);
  void* args[] = {&p};
  hipError_t e = hipLaunchCooperativeKernel((void*)megakernel, dim3(grid_blocks), dim3(256), args, 0, stream);
  if (e != hipSuccess) fprintf(stderr, "cooperative launch failed: %s (grid %d)\n", hipGetErrorString(e), grid_blocks);
}
#endif
```

```cpp
#ifndef HOST_TEST
#include <hip/hip_runtime.h>
#include <hip/hip_cooperative_groups.h>
#include <cstdio>
namespace cg = cooperative_groups;
#define HD __host__ __device__ __forceinline__
#else
#include <cmath>
#include <cstdio>
#include <cstdlib>
#include <cstring>
struct float4 { float x, y, z, w; };
#define HD inline
#endif
#include <math.h>
#include <stddef.h>
#include <string.h>

#ifndef CFG_BATCH
#define CFG_BATCH 4
#define CFG_SEQ 4096
#define CFG_CTX 256
#endif

constexpr int D = 1024, NB = CFG_BATCH, SEQ = CFG_SEQ, CTX = CFG_CTX;
constexpr int NT = SEQ + CTX;
constexpr int NTOK = NT;
constexpr int ATT_IN = 2208, REC_IN = 3088, PROJ_LD = 3088;
constexpr int MODROWS = NB + 1;
constexpr float EPS = 1e-6f;
constexpr float DN_ALPHA = 1.681792830507429f;
constexpr int A_CQ = 0, A_CKV = 256, A_KR = 384, A_GA = 416, A_QB = 928, A_KB = 1440, A_VB = 1568, A_GB = 1696;
constexpr int R_QKV = 0, R_Z = 1536, R_B = 2048, R_A = 2056, R_XR = 2064, R_GR = 2576;

struct Params {
  const float *x, *c, *ctx, *c_ctx, *mod_w, *mod_b, *ln_g, *ln_b, *att_w_in, *att_w_out, *mla_q_norm, *mla_w_uq,
      *mla_kv_norm, *mla_w_ukv, *gqa_q_norm, *gqa_k_norm, *rec_w_in, *rec_w_out, *gdn_conv_w, *gdn_a_log,
      *gdn_dt_bias, *gdn_norm, *lru_conv_w, *lru_conv_b, *lru_gate_w, *lru_gate_b, *lru_lambda;
  float* out;
  float *modv, *Xctx, *proj, *rinvq, *rinvkv, *qa_raw, *kv_raw, *QA, *KA, *QB, *KB, *mix, *y;
  float *gq, *gk, *gv, *gbeta, *gg, *xl, *la, *lb, *odir, *rdir;
  unsigned short *H, *mixh, *WtIn, *WtOut;
  unsigned short *CQ, *CKV, *QG, *KG, *VTG, *KRb, *GAB, *QN, *QR, *KN, *VTA, *Wuq, *Wukv;
  float *sqq, *sqkv, *ropeG, *ropeM;
  unsigned short *PQKV, *PZG, *PXR, *GQ, *GK, *GV, *TG, *ATTG, *ODIR, *WG;
  float *PBA, *GCB, *LCAR, *LHIN;
  unsigned* bar;
  char* ws;
};

HD unsigned short f2bf(float f) {
  unsigned u; memcpy(&u, &f, 4);
  u += 0x7fffu + ((u >> 16) & 1u);
  return (unsigned short)(u >> 16);
}
HD float sigmoidf_(float x) { return 1.0f / (1.0f + expf(-x)); }
HD float siluf_(float x) { return x / (1.0f + expf(-x)); }
HD float softplusf_(float x) { return x > 20.0f ? x : log1pf(expf(x)); }
HD float rsq_(float x) { return 1.0f / sqrtf(x); }
HD int tok_modrow(int b, int tok) { return tok < SEQ ? b : NB; }
HD float* xrow(const Params& p, int b, int tok) {
  return tok < SEQ ? p.out + ((size_t)b * SEQ + tok) * D : p.Xctx + ((size_t)b * CTX + (tok - SEQ)) * D;
}

HD void mod_item(const Params& p, long i) {
  int j = (int)(i % 3072);
  int r = (int)((i / 3072) % MODROWS);
  int l = (int)(i / (3072 * MODROWS));
  const float* cv = r < NB ? p.c + (size_t)r * D : p.c_ctx;
  const float* w = p.mod_w + (size_t)l * D * 3072 + j;
  float acc = 0.f;
  for (int k = 0; k < D; ++k) acc += siluf_(cv[k]) * w[(size_t)k * 3072];
  p.modv[i] = acc + p.mod_b[l * 3072 + j];
}

HD void copy_item(const Params& p, long i) {
  if (i < (long)NB * SEQ * D) p.out[i] = p.x[i];
  else p.Xctx[i - (long)NB * SEQ * D] = p.ctx[i - (long)NB * SEQ * D];
}

struct Gemm {
  const float* A; int lda; const float* W; int N; int K; float* C; int ldc;
  const float* rowscale; const float* kvec; const float* mod;
  const float* xlat; const float* xctx; int b;
};
HD void gemm_item(const Gemm& g, long item) {
  const int ncg = g.N / 4;
  const int rg = (int)(item / ncg), cgp = (int)(item % ncg);
  const int r0 = rg * 8, c0 = cgp * 4;
  float acc[8][4];
#pragma unroll
  for (int r = 0; r < 8; ++r)
#pragma unroll
    for (int c = 0; c < 4; ++c) acc[r][c] = 0.f;
  const bool hasmod = g.mod != nullptr;
  const bool haskv = g.kvec != nullptr;
  const float* modrow = hasmod ? g.mod + (size_t)tok_modrow(g.b, r0) * 3072 : g.W;
  const float* kvec = haskv ? g.kvec : g.W;
  const float* abase;
  size_t astride;
  if (g.xlat) {
    abase = r0 < SEQ ? g.xlat + ((size_t)g.b * SEQ + r0) * D : g.xctx + ((size_t)g.b * CTX + (r0 - SEQ)) * D;
    astride = D;
  } else {
    abase = g.A + (size_t)r0 * g.lda;
    astride = g.lda;
  }
  float rs[8];
#pragma unroll
  for (int r = 0; r < 8; ++r) rs[r] = g.rowscale ? g.rowscale[r0 + r] : 1.0f;
  for (int k = 0; k < g.K; k += 4) {
    float4 w[4];
#pragma unroll
    for (int kk = 0; kk < 4; ++kk) w[kk] = *(const float4*)(g.W + (size_t)(k + kk) * g.N + c0);
    float ks[4], kb[4];
#pragma unroll
    for (int kk = 0; kk < 4; ++kk) {
      ks[kk] = hasmod ? 1.0f + modrow[1024 + k + kk] : (haskv ? kvec[k + kk] : 1.0f);
      kb[kk] = hasmod ? modrow[k + kk] : 0.f;
    }
#pragma unroll
    for (int r = 0; r < 8; ++r) {
      float4 a = *(const float4*)(abase + (size_t)r * astride + k);
      float a0 = a.x * rs[r] * ks[0] + kb[0];
      float a1 = a.y * rs[r] * ks[1] + kb[1];
      float a2 = a.z * rs[r] * ks[2] + kb[2];
      float a3 = a.w * rs[r] * ks[3] + kb[3];
      acc[r][0] += a0 * w[0].x + a1 * w[1].x + a2 * w[2].x + a3 * w[3].x;
      acc[r][1] += a0 * w[0].y + a1 * w[1].y + a2 * w[2].y + a3 * w[3].y;
      acc[r][2] += a0 * w[0].z + a1 * w[1].z + a2 * w[2].z + a3 * w[3].z;
      acc[r][3] += a0 * w[0].w + a1 * w[1].w + a2 * w[2].w + a3 * w[3].w;
    }
  }
#pragma unroll
  for (int r = 0; r < 8; ++r) {
    float4 o; o.x = acc[r][0]; o.y = acc[r][1]; o.z = acc[r][2]; o.w = acc[r][3];
    *(float4*)(g.C + (size_t)(r0 + r) * g.ldc + c0) = o;
  }
}

HD void attnorm_item(const Params& p, long tok) {
  const float* pr = p.proj + (size_t)tok * PROJ_LD;
  float s = 0.f;
  for (int k = 0; k < 256; ++k) s += pr[A_CQ + k] * pr[A_CQ + k];
  p.rinvq[tok] = rsq_(s / 256.0f + EPS);
  s = 0.f;
  for (int k = 0; k < 128; ++k) s += pr[A_CKV + k] * pr[A_CKV + k];
  p.rinvkv[tok] = rsq_(s / 128.0f + EPS);
}

template <int NH>
HD void rope_apply(const float* in, float* out, int row, int col) {
  constexpr int Q = NH / 2;
#pragma unroll
  for (int i = 0; i < Q; ++i) {
    float inv = powf(10000.0f, -(float)(2 * i) / (float)NH);
    float ar = (float)row * inv, ac = (float)col * inv;
    float cr = cosf(ar), sr = sinf(ar), cc = cosf(ac), sc = sinf(ac);
    float x1 = in[i], x2 = in[Q + i];
    out[i] = x1 * cr - x2 * sr;
    out[Q + i] = x1 * sr + x2 * cr;
    float y1 = in[NH + i], y2 = in[NH + Q + i];
    out[NH + i] = y1 * cc - y2 * sc;
    out[NH + Q + i] = y1 * sc + y2 * cc;
  }
}

HD void assemble_item(const Params& p, int li, long i) {
  const int h = (int)(i & 7);
  const int tok = (int)(i >> 3);
  const bool lat = tok < SEQ;
  const int t = lat ? tok : 0;
  const int row = t / 64, col = t % 64;
  const float* pr = p.proj + (size_t)tok * PROJ_LD;
  {
    const float* qr = p.qa_raw + (size_t)tok * 768 + h * 96;
    float* qo = p.QA + ((size_t)tok * 8 + h) * 96;
    for (int d = 0; d < 64; ++d) qo[d] = qr[d];
    if (lat) rope_apply<16>(qr + 64, qo + 64, row, col);
    else for (int d = 64; d < 96; ++d) qo[d] = qr[d];
  }
  {
    const float* kr = p.kv_raw + (size_t)tok * 1024 + h * 128;
    float* ko = p.KA + ((size_t)tok * 8 + h) * 96;
    for (int d = 0; d < 64; ++d) ko[d] = kr[d];
    if (lat) rope_apply<16>(pr + A_KR, ko + 64, row, col);
    else for (int d = 0; d < 32; ++d) ko[64 + d] = pr[A_KR + d];
  }
  {
    const float* q = pr + A_QB + h * 64;
    const float* nw = p.gqa_q_norm + li * 64;
    float* qo = p.QB + ((size_t)tok * 8 + h) * 64;
    float s = 0.f;
    for (int d = 0; d < 64; ++d) s += q[d] * q[d];
    float rinv = rsq_(s / 64.0f + EPS);
    for (int d = 0; d < 64; ++d) qo[d] = q[d] * rinv * nw[d];
    if (lat) rope_apply<32>(qo, qo, row, col);
  }
  if (h < 2) {
    const float* q = pr + A_KB + h * 64;
    const float* nw = p.gqa_k_norm + li * 64;
    float* qo = p.KB + ((size_t)tok * 2 + h) * 64;
    float s = 0.f;
    for (int d = 0; d < 64; ++d) s += q[d] * q[d];
    float rinv = rsq_(s / 64.0f + EPS);
    for (int d = 0; d < 64; ++d) qo[d] = q[d] * rinv * nw[d];
    if (lat) rope_apply<32>(qo, qo, row, col);
  }
}

template <int DQK>
HD void attn_item(const Params& p, int b, int mixer, int h, int tok) {
  const float* qp = mixer == 0 ? p.QA + ((size_t)tok * 8 + h) * 96 : p.QB + ((size_t)tok * 8 + h) * 64;
  float q[DQK];
  const float scale = mixer == 0 ? 0.10206207261596575f : 0.125f;
#pragma unroll
  for (int d = 0; d < DQK; ++d) q[d] = qp[d] * scale;
  float o[64];
#pragma unroll
  for (int d = 0; d < 64; ++d) o[d] = 0.f;
  float mx = -1e30f, l = 0.f;
  const bool lat = tok < SEQ;
  for (int seg = 0; seg < (lat ? 2 : 1); ++seg) {
    const int k0 = seg == 0 ? SEQ : 0;
    const int kn = seg == 0 ? CTX : SEQ;
    for (int kk = 0; kk < kn; ++kk) {
      const int kt = k0 + kk;
      const float* kp = mixer == 0 ? p.KA + ((size_t)kt * 8 + h) * 96 : p.KB + ((size_t)kt * 2 + (h >> 2)) * 64;
      const float* vp = mixer == 0 ? p.kv_raw + (size_t)kt * 1024 + h * 128 + 64
                                   : p.proj + (size_t)kt * PROJ_LD + A_VB + (h >> 2) * 64;
      float s = 0.f;
#pragma unroll
      for (int d = 0; d < DQK; d += 4) {
        float4 kv = *(const float4*)(kp + d);
        s += q[d] * kv.x + q[d + 1] * kv.y + q[d + 2] * kv.z + q[d + 3] * kv.w;
      }
      float mn = fmaxf(mx, s);
      float alpha = expf(mx - mn);
      float pe = expf(s - mn);
      l = l * alpha + pe;
      mx = mn;
#pragma unroll
      for (int d = 0; d < 64; d += 4) {
        float4 vv = *(const float4*)(vp + d);
        o[d] = o[d] * alpha + pe * vv.x;
        o[d + 1] = o[d + 1] * alpha + pe * vv.y;
        o[d + 2] = o[d + 2] * alpha + pe * vv.z;
        o[d + 3] = o[d + 3] * alpha + pe * vv.w;
      }
    }
  }
  const float invl = 1.0f / l;
  const float* gate = p.proj + (size_t)tok * PROJ_LD + (mixer == 0 ? A_GA : A_GB) + h * 64;
  float* mo = p.mix + (size_t)tok * 1024 + mixer * 512 + h * 64;
  unsigned short* mh = p.mixh + ((size_t)b * NT + tok) * 1024 + mixer * 512 + h * 64;
#pragma unroll
  for (int d = 0; d < 64; ++d) {
    float v = o[d] * invl * siluf_(gate[d]);
#ifdef HOST_TEST
    mo[d] = v;
#endif
    mh[d] = f2bf(v);
  }
  (void)mo;
}

HD void ln_item(const Params& p, int layer, int b, long tok) {
  const float* modrow = p.modv + ((size_t)layer * MODROWS + tok_modrow(b, (int)tok)) * 3072 + 2048;
  float* xr = xrow(p, b, (int)tok);
  const float* yr = p.y + (size_t)tok * D;
  float s = 0.f;
  for (int j = 0; j < D; ++j) s += DN_ALPHA * xr[j] + modrow[j] * yr[j];
  const float mu = s / D;
  float v = 0.f;
  for (int j = 0; j < D; ++j) { float z = DN_ALPHA * xr[j] + modrow[j] * yr[j] - mu; v += z * z; }
  const float rstd = rsq_(v / D + EPS);
  const float* g = p.ln_g + layer * D;
  const float* bb = p.ln_b + layer * D;
  float* dst = xr;
  const float* modn = layer < 3 ? p.modv + ((size_t)(layer + 1) * MODROWS + tok_modrow(b, (int)tok)) * 3072 : nullptr;
  unsigned short* hrow = p.H + ((size_t)b * NT + tok) * D;
  for (int j = 0; j < D; ++j) {
    float z = DN_ALPHA * xr[j] + modrow[j] * yr[j];
    float xn = (z - mu) * rstd * g[j] + bb[j];
    dst[j] = xn;
    if (modn) hrow[j] = f2bf(xn * (1.0f + modn[1024 + j]) + modn[j]);
  }
}

HD void h0_item(const Params& p, long i) {
  const int j = (int)(i % D);
  const int tok = (int)((i / D) % NT);
  const int b = (int)(i / ((long)D * NT));
  const float* modn = p.modv + ((size_t)tok_modrow(b, tok)) * 3072;
  const float xv = tok < SEQ ? p.x[((size_t)b * SEQ + tok) * D + j] : p.ctx[((size_t)b * CTX + (tok - SEQ)) * D + j];
  p.H[i] = f2bf(xv * (1.0f + modn[1024 + j]) + modn[j]);
}

constexpr int ATT_NPAD = 2304, REC_NPAD = 3200;
constexpr int WT_IN_ROWS = 2 * ATT_NPAD + 2 * REC_NPAD;
HD size_t wtin_row0(int layer) { return (size_t)(layer >> 1) * (ATT_NPAD + REC_NPAD) + ((layer & 1) ? ATT_NPAD : 0); }
HD void wconv_item(const float* src, int nsrc, unsigned short* dst, long i) {
  const int kg = (int)(i & 63);
  const int col = (int)(i >> 6);
  unsigned* d32 = (unsigned*)(dst + (size_t)col * D + kg * 16);
#pragma unroll
  for (int t = 0; t < 8; ++t) {
    unsigned lo = 0, hi = 0;
    if (col < nsrc) {
      lo = f2bf(src[(size_t)(kg * 16 + 2 * t) * nsrc + col]);
      hi = f2bf(src[(size_t)(kg * 16 + 2 * t + 1) * nsrc + col]);
    }
    d32[t] = lo | (hi << 16);
  }
}

HD float conv4(const Params& p, int tok, int colidx, const float* w, int wstride, int c) {
  const bool lat = tok < SEQ;
  const int T = lat ? SEQ : CTX;
  const int t = lat ? tok : tok - SEQ;
  float acc = 0.f;
#pragma unroll
  for (int j = 0; j < 4; ++j) {
    int tt = t - 1 + j;
    if (tt >= 0 && tt < T) acc += w[j * wstride + c] * p.proj[(size_t)(tok - 1 + j) * PROJ_LD + colidx];
  }
  return acc;
}

HD void recpre_item(const Params& p, int li, long i) {
  const int slot = (int)(i % 17);
  const int tok = (int)(i / 17);
  if (slot < 12) {
    const int part = slot >> 2, hh = slot & 3;
    const int cb = part * 512 + hh * 128;
    const float* w = p.gdn_conv_w + (size_t)li * 4 * 1536;
    float ss = 0.f;
    if (part < 2) {
      for (int c = 0; c < 128; ++c) { float v = siluf_(conv4(p, tok, R_QKV + cb + c, w, 1536, cb + c)); ss += v * v; }
    }
    float sc = part < 2 ? rsq_(ss + EPS) : 1.0f;
    if (part == 0) sc *= 0.08838834764831845f;
    float* dst = (part == 0 ? p.gq + 0 : part == 1 ? p.gk + 0 : p.gv + 0) + ((size_t)tok * 4 + hh) * 128;
    for (int c = 0; c < 128; ++c) dst[c] = siluf_(conv4(p, tok, R_QKV + cb + c, w, 1536, cb + c)) * sc;
  } else if (slot == 12) {
    const float* pr = p.proj + (size_t)tok * PROJ_LD;
    for (int j = 0; j < 8; ++j) {
      p.gbeta[(size_t)tok * 8 + j] = sigmoidf_(pr[R_B + j]);
      p.gg[(size_t)tok * 8 + j] = -expf(p.gdn_a_log[li * 8 + j]) * softplusf_(pr[R_A + j] + p.gdn_dt_bias[li * 8 + j]);
    }
  } else {
    const int cb = (slot - 13) * 128;
    const float* w = p.lru_conv_w + (size_t)li * 4 * 512;
    for (int c = 0; c < 128; ++c)
      p.xl[(size_t)tok * 512 + cb + c] = conv4(p, tok, R_XR + cb + c, w, 512, cb + c) + p.lru_conv_b[li * 512 + cb + c];
  }
}

HD void lrucoef_item(const Params& p, int li, long i) {
  const int ch = (int)(i & 511);
  const int tok = (int)((i >> 9) % NTOK);
  const int d = (int)((i >> 9) / NTOK);
  const int n = ch >> 6, dd = ch & 63;
  const float* xb = p.xl + (size_t)tok * 512 + n * 64;
  const float* w0 = p.lru_gate_w + ((((size_t)li * 2 + d) * 2 + 0) * 8 + n) * 4096 + dd;
  const float* w1 = p.lru_gate_w + ((((size_t)li * 2 + d) * 2 + 1) * 8 + n) * 4096 + dd;
  float g0 = 0.f, g1 = 0.f;
  for (int c = 0; c < 64; ++c) { g0 += xb[c] * w0[c * 64]; g1 += xb[c] * w1[c * 64]; }
  g0 += p.lru_gate_b[(((size_t)li * 2 + d) * 2 + 0) * 512 + ch];
  g1 += p.lru_gate_b[(((size_t)li * 2 + d) * 2 + 1) * 512 + ch];
  const float r = sigmoidf_(g0), ig = sigmoidf_(g1);
  const float lam = p.lru_lambda[((size_t)li * 2 + d) * 512 + ch];
  const float log_a = 8.0f * r * (-softplusf_(-lam));
  p.la[((size_t)d * NTOK + tok) * 512 + ch] = expf(log_a);
  p.lb[((size_t)d * NTOK + tok) * 512 + ch] = sqrtf(-expm1f(2.0f * log_a)) * (ig * p.xl[(size_t)tok * 512 + ch]);
}

HD void gdnseq_item(const Params& p, long i) {
  const int col = (int)(i & 127);
  const int hh = (int)((i >> 7) & 3);
  const int d = (int)((i >> 9) & 1);
  float S[128];
#pragma unroll
  for (int k = 0; k < 128; ++k) S[k] = 0.f;
  for (int seg = 0; seg < 2; ++seg) {
    const int base = seg == 0 ? SEQ : 0;
    const int T = seg == 0 ? CTX : SEQ;
    for (int step = 0; step < T; ++step) {
      const int tok = base + (d == 0 ? step : T - 1 - step);
      const float a = expf(p.gg[(size_t)tok * 8 + d * 4 + hh]);
      const float beta = p.gbeta[(size_t)tok * 8 + d * 4 + hh];
      const float* kp = p.gk + ((size_t)tok * 4 + hh) * 128;
      const float* qp = p.gq + ((size_t)tok * 4 + hh) * 128;
      const float v = p.gv[((size_t)tok * 4 + hh) * 128 + col];
      float dot = 0.f;
#pragma unroll
      for (int k = 0; k < 128; k += 4) {
        float4 kv = *(const float4*)(kp + k);
        S[k] *= a; S[k + 1] *= a; S[k + 2] *= a; S[k + 3] *= a;
        dot += kv.x * S[k] + kv.y * S[k + 1] + kv.z * S[k + 2] + kv.w * S[k + 3];
      }
      const float vn = beta * (v - dot);
      float o = 0.f;
#pragma unroll
      for (int k = 0; k < 128; k += 4) {
        float4 kv = *(const float4*)(kp + k);
        float4 qv = *(const float4*)(qp + k);
        S[k] += kv.x * vn; S[k + 1] += kv.y * vn; S[k + 2] += kv.z * vn; S[k + 3] += kv.w * vn;
        o += qv.x * S[k] + qv.y * S[k + 1] + qv.z * S[k + 2] + qv.w * S[k + 3];
      }
      p.odir[(((size_t)d * NTOK + tok) * 4 + hh) * 128 + col] = o;
    }
  }
}

HD void lruseq_item(const Params& p, long i) {
  const int ch = (int)(i & 511);
  const int d = (int)((i >> 9) & 1);
  float h = 0.f;
  for (int seg = 0; seg < 2; ++seg) {
    const int base = seg == 0 ? SEQ : 0;
    const int T = seg == 0 ? CTX : SEQ;
    for (int step = 0; step < T; ++step) {
      const int tok = base + (d == 0 ? step : T - 1 - step);
      const size_t idx = ((size_t)d * NTOK + tok) * 512 + ch;
      h = p.la[idx] * h + p.lb[idx];
      p.rdir[idx] = h;
    }
  }
}

HD void recout_item(const Params& p, int li, int b, long i) {
  const int slot = (int)(i & 7);
  const int tok = (int)(i >> 3);
  const float* pr = p.proj + (size_t)tok * PROJ_LD;
  float* mo = p.mix + (size_t)tok * 1024;
  if (slot < 4) {
    const float* o0 = p.odir + (((size_t)0 * NTOK + tok) * 4 + slot) * 128;
    const float* o1 = p.odir + (((size_t)1 * NTOK + tok) * 4 + slot) * 128;
    float ss = 0.f;
    for (int c = 0; c < 128; ++c) { float o = o0[c] + o1[c]; ss += o * o; }
    const float rinv = rsq_(ss / 128.0f + EPS);
    for (int c = 0; c < 128; ++c) {
      float v = (o0[c] + o1[c]) * rinv * p.gdn_norm[li * 128 + c] * siluf_(pr[R_Z + slot * 128 + c]);
#ifdef HOST_TEST
      mo[slot * 128 + c] = v;
#endif
      p.mixh[((size_t)b * NT + tok) * 1024 + slot * 128 + c] = f2bf(v);
    }
  } else {
    const int cb = (slot - 4) * 128;
    for (int c = 0; c < 128; ++c) {
      const int ch = cb + c;
      float r = p.rdir[((size_t)0 * NTOK + tok) * 512 + ch] + p.rdir[((size_t)1 * NTOK + tok) * 512 + ch];
      float v = r * siluf_(pr[R_GR + ch]);
#ifdef HOST_TEST
      mo[512 + ch] = v;
#endif
      p.mixh[((size_t)b * NT + tok) * 1024 + 512 + ch] = f2bf(v);
    }
  }
}

#ifdef HOST_TEST
enum { K_GEMM = 0, K_ATTNORM, K_ASSEMBLE, K_ATTN, K_LN, K_RECPRE, K_LRUCOEF, K_GDNSEQ, K_LRUSEQ, K_RECOUT };

HD void make_op(const Params& p, int layer, int b, int ph, int& kind, long& n, Gemm& g) {
  const int li = layer >> 1;
  const bool last = layer == 3;
  const bool att = (layer & 1) == 0;
  const float* modl = p.modv + (size_t)layer * MODROWS * 3072;
  g.A = p.mix; g.lda = D; g.W = p.att_w_out; g.N = D; g.K = D; g.C = p.y; g.ldc = D;
  g.rowscale = nullptr; g.kvec = nullptr; g.mod = nullptr; g.xlat = nullptr; g.xctx = nullptr; g.b = b;
  kind = K_GEMM; n = 0;
  if (ph == 0) {
    g.A = p.out; g.xlat = p.out; g.xctx = p.Xctx; g.mod = modl; g.C = p.proj; g.ldc = PROJ_LD;
    g.W = att ? p.att_w_in + (size_t)li * D * ATT_IN : p.rec_w_in + (size_t)li * D * REC_IN;
    g.N = att ? ATT_IN : REC_IN;
    n = (long)(NT / 8) * (g.N / 4);
  } else if (ph == 6) {
    g.W = att ? p.att_w_out + (size_t)li * D * D : p.rec_w_out + (size_t)li * D * D;
    n = (long)(NT / 8) * (D / 4);
  } else if (ph == 7) {
    kind = K_LN; n = last ? SEQ : NT;
  } else if (att) {
    if (ph == 1) { kind = K_ATTNORM; n = NT; }
    else if (ph == 2) {
      g.A = p.proj + A_CQ; g.lda = PROJ_LD; g.W = p.mla_w_uq + (size_t)li * 256 * 768; g.N = 768; g.K = 256;
      g.C = p.qa_raw; g.ldc = 768; g.rowscale = p.rinvq; g.kvec = p.mla_q_norm + li * 256;
      n = (long)(NT / 8) * (768 / 4);
    } else if (ph == 3) {
      g.A = p.proj + A_CKV; g.lda = PROJ_LD; g.W = p.mla_w_ukv + (size_t)li * 128 * 1024; g.N = 1024; g.K = 128;
      g.C = p.kv_raw; g.ldc = 1024; g.rowscale = p.rinvkv; g.kvec = p.mla_kv_norm + li * 128;
      n = (long)(NT / 8) * (1024 / 4);
    } else if (ph == 4) { kind = K_ASSEMBLE; n = (long)NT * 8; }
    else { kind = K_ATTN; n = (long)NT * 16; }
  } else {
    if (ph == 1) { kind = K_RECPRE; n = (long)NT * 17; }
    else if (ph == 2) { kind = K_LRUCOEF; n = (long)2 * NT * 512; }
    else if (ph == 3) { kind = K_GDNSEQ; n = 2 * 4 * 128; }
    else if (ph == 4) { kind = K_LRUSEQ; n = 2 * 512; }
    else { kind = K_RECOUT; n = (long)NT * 8; }
  }
}

#ifdef HOST_TEST
#define FOR_ITEMS(n) _Pragma("omp parallel for schedule(dynamic, 16)") for (long i = 0; i < (long)(n); ++i)
#define GRID_SYNC()
void forward_host(const Params& p)
#else
#define FOR_ITEMS(n) for (long i = gtid; i < (long)(n); i += gstride)
#define GRID_SYNC() grid.sync()
__global__ void __launch_bounds__(256) megakernel(Params p)
#endif
{
#ifndef HOST_TEST
  cg::grid_group grid = cg::this_grid();
  const long gtid = (long)blockIdx.x * blockDim.x + threadIdx.x;
  const long gstride = (long)gridDim.x * blockDim.x;
#endif
  FOR_ITEMS((long)4 * MODROWS * 3072) { mod_item(p, i); }
  FOR_ITEMS((long)NB * NT * D) { copy_item(p, i); }
  GRID_SYNC();
  for (int step = 0; step < 4 * NB * 8; ++step) {
    const int layer = step / (NB * 8);
    const int b = (step / 8) % NB;
    const int ph = step & 7;
    const int li = layer >> 1;
    int kind; long n; Gemm g;
    make_op(p, layer, b, ph, kind, n, g);
    FOR_ITEMS(n) {
      switch (kind) {
        case K_GEMM: gemm_item(g, i); break;
        case K_ATTNORM: attnorm_item(p, i); break;
        case K_ASSEMBLE: assemble_item(p, li, i); break;
        case K_ATTN: {
          const int tok = (int)(i % NT);
          const int mh = (int)(i / NT);
          if (mh < 8) attn_item<96>(p, b, 0, mh, tok);
          else attn_item<64>(p, b, 1, mh - 8, tok);
        } break;
        case K_LN: ln_item(p, layer, b, i); break;
        case K_RECPRE: recpre_item(p, li, i); break;
        case K_LRUCOEF: lrucoef_item(p, li, i); break;
        case K_GDNSEQ: gdnseq_item(p, i); break;
        case K_LRUSEQ: lruseq_item(p, i); break;
        default: recout_item(p, li, b, i); break;
      }
    }
    GRID_SYNC();
  }
}

static size_t carve(Params& p, float* ws) {
  size_t off = 0;
  auto take = [&](size_t n) { float* r = ws + off; off += (n + 63) & ~(size_t)63; return r; };
  p.modv = take((size_t)4 * MODROWS * 3072);
  p.Xctx = take((size_t)NB * CTX * D);
  p.H = (unsigned short*)take((size_t)NB * NT * D / 2);
  p.mixh = (unsigned short*)take((size_t)NB * NT * D / 2);
  p.proj = take((size_t)NT * PROJ_LD);
  p.mix = take((size_t)NT * 1024);
  p.y = take((size_t)NT * 1024);
  const size_t mark = off;
  p.rinvq = take(NT);
  p.rinvkv = take(NT);
  p.qa_raw = take((size_t)NT * 768);
  p.kv_raw = take((size_t)NT * 1024);
  p.QA = take((size_t)NT * 8 * 96);
  p.KA = take((size_t)NT * 8 * 96);
  p.QB = take((size_t)NT * 8 * 64);
  p.KB = take((size_t)NT * 2 * 64);
  const size_t end_att = off;
  off = mark;
  p.gq = take((size_t)NT * 512);
  p.gk = take((size_t)NT * 512);
  p.gv = take((size_t)NT * 512);
  p.gbeta = take((size_t)NT * 8);
  p.gg = take((size_t)NT * 8);
  p.xl = take((size_t)NT * 512);
  p.la = take((size_t)2 * NT * 512);
  p.lb = take((size_t)2 * NT * 512);
  p.odir = take((size_t)2 * NT * 512);
  p.rdir = take((size_t)2 * NT * 512);
  return (off > end_att ? off : end_att) * sizeof(float);
}

#endif

#ifndef HOST_TEST
typedef __attribute__((ext_vector_type(8))) __bf16 bf8_t;
typedef __attribute__((ext_vector_type(4))) __bf16 bf4_t;
typedef __attribute__((ext_vector_type(16))) float f32x16;
typedef unsigned short bf16_t;
constexpr int NALL = NB * NT;
constexpr int LDT = 72;
constexpr int GEMM_LDS = 2 * 2 * 128 * 64 * 2;
constexpr float LOG2E = 1.4426950408889634f;
constexpr int LDS_BYTES = 79872;
constexpr int XB_LDS_OFF = LDS_BYTES - 16;
constexpr int NCH = NT / 64;
constexpr int NCH_LAT = SEQ / 64;
#define XCD_BAR_WORDS 3456
constexpr size_t ws_al(size_t x) { return (x + 255) & ~(size_t)255; }
struct WsOff {
  static constexpr size_t bar = 0;
  static constexpr size_t bar_end = bar + ws_al(XCD_BAR_WORDS * 4);
  static constexpr size_t modv = bar_end;
  static constexpr size_t modv_end = modv + ws_al(4 * MODROWS * 3072 * 4);
  static constexpr size_t ropeG = modv_end;
  static constexpr size_t ropeG_end = ropeG + ws_al(64 * 16 * 2 * 4);
  static constexpr size_t ropeM = ropeG_end;
  static constexpr size_t ropeM_end = ropeM + ws_al(64 * 8 * 2 * 4);
  static constexpr size_t Xctx = ropeM_end;
  static constexpr size_t Xctx_end = Xctx + ws_al((size_t)NB * CTX * D * 4);
  static constexpr size_t WtIn = Xctx_end;
  static constexpr size_t WtIn_end = WtIn + ws_al((size_t)REC_NPAD * D * 2);
  static constexpr size_t Wuq = WtIn_end;
  static constexpr size_t Wuq_end = Wuq + ws_al((size_t)2 * 768 * 256 * 2);
  static constexpr size_t Wukv = Wuq_end;
  static constexpr size_t Wukv_end = Wukv + ws_al((size_t)2 * 1024 * 128 * 2);
  static constexpr size_t WG = Wukv_end;
  static constexpr size_t WG_end = WG + ws_al((size_t)64 * 4096 * 2);
  static constexpr size_t LHIN = WG_end;
  static constexpr size_t LHIN_end = LHIN + ws_al((size_t)NB * 2 * NCH * 512 * 4);
  static constexpr size_t LNS = LHIN_end;
  static constexpr size_t LNS_end = LNS + ws_al((size_t)NALL * 2 * 4);
  static constexpr size_t GCB = LNS_end;
  static constexpr size_t GCB_end = GCB + ws_al((size_t)NB * 2 * 4 * NT * 2 * 4);
  static constexpr size_t LCAR = GCB_end;
  static constexpr size_t LCAR_end = LCAR + ws_al((size_t)NB * 2 * NCH * 512 * 2 * 4);
  static constexpr size_t H = LCAR_end;
  static constexpr size_t H_end = H + ws_al((size_t)NALL * D * 2);
  static constexpr size_t ATTG = H;
  static constexpr size_t TG = H + (size_t)NB * NCH * 4 * 2 * 4096 * 2;
  static constexpr size_t mixh = H_end;
  static constexpr size_t mixh_end = mixh + ws_al((size_t)NALL * D * 2);
  static constexpr size_t mark_ = mixh_end;
  static constexpr size_t CQ = mixh_end;
  static constexpr size_t CQ_end = CQ + ws_al((size_t)NALL * 256 * 2);
  static constexpr size_t CKV = CQ_end;
  static constexpr size_t CKV_end = CKV + ws_al((size_t)NALL * 128 * 2);
  static constexpr size_t sqq = CKV_end;
  static constexpr size_t sqq_end = sqq + ws_al((size_t)NALL * 4 * 4);
  static constexpr size_t sqkv = sqq_end;
  static constexpr size_t sqkv_end = sqkv + ws_al((size_t)NALL * 2 * 4);
  static constexpr size_t QG = sqkv_end;
  static constexpr size_t QG_end = QG + ws_al((size_t)NALL * 512 * 2);
  static constexpr size_t KG = QG_end;
  static constexpr size_t KG_end = KG + ws_al((size_t)NALL * 128 * 2);
  static constexpr size_t VTG = KG_end;
  static constexpr size_t VTG_end = VTG + ws_al((size_t)NB * 2 * 64 * NT * 2);
  static constexpr size_t KRb = VTG_end;
  static constexpr size_t KRb_end = KRb + ws_al((size_t)NALL * 32 * 2);
  static constexpr size_t GAB = KRb_end;
  static constexpr size_t GAB_end = GAB + ws_al((size_t)NALL * 1024 * 2);
  static constexpr size_t QN = GAB_end;
  static constexpr size_t QN_end = QN + ws_al((size_t)NALL * 512 * 2);
  static constexpr size_t QR = QN_end;
  static constexpr size_t QR_end = QR + ws_al((size_t)NALL * 256 * 2);
  static constexpr size_t KN = QR_end;
  static constexpr size_t KN_end = KN + ws_al((size_t)NALL * 512 * 2);
  static constexpr size_t VTA = KN_end;
  static constexpr size_t VTA_end = VTA + ws_al((size_t)NB * 8 * 64 * NT * 2);
  static constexpr size_t endatt_ = VTA_end;
  static constexpr size_t PQKV = mark_;
  static constexpr size_t PQKV_end = PQKV + ws_al((size_t)NALL * 1536 * 2);
  static constexpr size_t PZG = PQKV_end;
  static constexpr size_t PZG_end = PZG + ws_al((size_t)NALL * 1024 * 2);
  static constexpr size_t PXR = PZG_end;
  static constexpr size_t PXR_end = PXR + ws_al((size_t)NALL * 512 * 2);
  static constexpr size_t PBA = PXR_end;
  static constexpr size_t PBA_end = PBA + ws_al((size_t)NALL * 16 * 4);
  static constexpr size_t GQ = PBA_end;
  static constexpr size_t GQ_end = GQ + ws_al((size_t)NALL * 512 * 2);
  static constexpr size_t GK = GQ_end;
  static constexpr size_t GK_end = GK + ws_al((size_t)NALL * 512 * 2);
  static constexpr size_t GV = GK_end;
  static constexpr size_t GV_end = GV + ws_al((size_t)NALL * 512 * 2);
  static constexpr size_t OD1 = GV_end;
  static constexpr size_t OD1_end = OD1 + ws_al((size_t)NALL * 512 * 2);
  static constexpr size_t endrec_ = OD1_end;
  static constexpr size_t total = endatt_ > endrec_ ? endatt_ : endrec_;
};


__device__ __forceinline__ int acc_row(int reg, int lane) { return (reg & 3) + 8 * (reg >> 2) + 4 * (lane >> 5); }
__device__ __forceinline__ float bf2f(bf16_t v) { return __uint_as_float((unsigned)v << 16); }
__device__ __forceinline__ uint2 pack4(float a, float b, float c, float d) {
  bf4_t v; v[0] = (__bf16)a; v[1] = (__bf16)b; v[2] = (__bf16)c; v[3] = (__bf16)d;
  return *(uint2*)&v;
}
__device__ __forceinline__ bf16_t f2bf_dev(float a) { __bf16 v = (__bf16)a; return *(bf16_t*)&v; }
__device__ __forceinline__ Params phase_params(const Params& q) {
  Params r = q;
  size_t zero = 0;
  asm volatile("" : "+s"(zero));
  r.ws = q.ws + zero;
  return r;
}
__device__ __forceinline__ int wave_index() {
  int wv = __builtin_amdgcn_readfirstlane((int)(threadIdx.x >> 6));
  asm volatile("" : "+s"(wv));
  return wv;
}
__device__ __forceinline__ int opaque_tid(int wv) {
  int lane;
  asm volatile("v_mbcnt_lo_u32_b32 %0, -1, 0\n\tv_mbcnt_hi_u32_b32 %0, -1, %0" : "=v"(lane));
  return (wv << 6) | lane;
}
__device__ __forceinline__ float silu_fast(float g) { return g / (1.0f + __expf(-g)); }


#define XB_TMO      128
#define XB_XCNT(j)  (256  + 64 * (j))
#define XB_XSUB(j)  (1280 + 64 * (j))
#define XB_XGEN(j)  (2304 + 64 * (j))
#define XB_TOP      3328
#define XB_TOPGEN   3392
#define XB_SPIN_CAP (1u << 22)
__device__ __forceinline__ unsigned xb_ld(unsigned* p) { return __hip_atomic_load(p, __ATOMIC_RELAXED, __HIP_MEMORY_SCOPE_AGENT); }
__device__ __forceinline__ unsigned xb_add(unsigned* p, unsigned v) { return __hip_atomic_fetch_add(p, v, __ATOMIC_RELAXED, __HIP_MEMORY_SCOPE_AGENT); }
__device__ __forceinline__ unsigned xb_xcc_id() { return (unsigned)__builtin_amdgcn_s_getreg((3 << 11) | 20) & 0xFu; }
#define XB_SPIN(cond, bar) do { unsigned _sp = 0; while (cond) { __builtin_amdgcn_s_sleep(1); \
    if ((++_sp & 255u) == 0u) { if (xb_ld(&(bar)[XB_TMO])) break; if (_sp > XB_SPIN_CAP) { atomicAdd(&(bar)[XB_TMO], 1u); break; } } } } while (0)
__device__ __forceinline__ void xcd_barrier_post(unsigned* bar, int tid) {
  if (tid == 0) (void)xb_add(&bar[XB_XCNT(xb_xcc_id())], 1u);
}
__device__ __forceinline__ void xcd_barrier_complete(unsigned* bar, unsigned x, unsigned& nloc, unsigned& nx) {
  const unsigned G = gridDim.x;
  unsigned sum, cnt, mine, sp = 0u;
  for (;;) {
    sum = 0u; cnt = 0u; mine = 0u;
#pragma unroll
    for (unsigned j = 0; j < 16; ++j) { const unsigned c = xb_ld(&bar[XB_XCNT(j)]); sum += c; cnt += (c > 0u) ? 1u : 0u; mine = (j == x) ? c : mine; }
    if (sum == G) break;
    __builtin_amdgcn_s_sleep(1);
    if ((++sp & 255u) == 0u) { if (xb_ld(&bar[XB_TMO])) break; if (sp > XB_SPIN_CAP) { atomicAdd(&bar[XB_TMO], 1u); break; } }
  }
  nloc = mine > 0u ? mine : 1u; nx = cnt > 0u ? cnt : 1u;
}
__device__ __forceinline__ void xcd_barrier(unsigned* bar, int tid) {
  volatile __attribute__((address_space(3))) unsigned* st = (volatile __attribute__((address_space(3))) unsigned*)(size_t)XB_LDS_OFF;
  asm volatile("s_waitcnt vmcnt(0)" ::: "memory");
  __syncthreads();
  if (tid == 0) {
    __builtin_amdgcn_s_waitcnt(0);
    const unsigned x = xb_xcc_id();
    unsigned nloc = st[0], nx = st[1];
    if (nloc == 0u) { xcd_barrier_complete(bar, x, nloc, nx); st[0] = nloc; st[1] = nx; }
    const unsigned old = xb_add(&bar[XB_XSUB(x)], 1u);
    const unsigned gen = old / nloc;
    if (old + 1u == (gen + 1u) * nloc) {
      __builtin_amdgcn_fence(__ATOMIC_RELEASE, "agent");
      asm volatile("s_waitcnt vmcnt(0)" ::: "memory");
      const unsigned og = xb_add(&bar[XB_TOP], 1u);
      const unsigned tg = og / nx;
      if (og + 1u == (tg + 1u) * nx) xb_add(&bar[XB_TOPGEN], 1u);
      else XB_SPIN(xb_ld(&bar[XB_TOPGEN]) == tg, bar);
      __builtin_amdgcn_fence(__ATOMIC_ACQUIRE, "agent");
      xb_add(&bar[XB_XGEN(x)], 1u);
      asm volatile("s_waitcnt vmcnt(0)" ::: "memory");
    } else {
      XB_SPIN(xb_ld(&bar[XB_XGEN(x)]) == gen, bar);
      __builtin_amdgcn_fence(__ATOMIC_ACQUIRE, "agent");
      asm volatile("s_waitcnt vmcnt(0)" ::: "memory");
    }
  }
  __syncthreads();
}


__device__ __forceinline__ int next_unit(unsigned* ctr, char* smem, int tid) {
  volatile int* slot = (volatile int*)(smem + XB_LDS_OFF + 8);
  __syncthreads();
  if (tid == 0) *slot = (int)__hip_atomic_fetch_add(ctr, 1u, __ATOMIC_RELAXED, __HIP_MEMORY_SCOPE_AGENT);
  __syncthreads();
  return *slot;
}


__device__ __forceinline__ void signal_add(unsigned* ctr, unsigned v, int tid) {
  asm volatile("s_waitcnt vmcnt(0)" ::: "memory");
  __syncthreads();
  if (tid == 0) {
    __builtin_amdgcn_fence(__ATOMIC_RELEASE, "agent");
    asm volatile("s_waitcnt vmcnt(0)" ::: "memory");
    (void)__hip_atomic_fetch_add(ctr, v, __ATOMIC_RELAXED, __HIP_MEMORY_SCOPE_AGENT);
  }
}
__device__ __forceinline__ void wait_ge(unsigned* ctr, unsigned target, int tid) {
  if (tid == 0) {
    unsigned spins = 0;
    while (__hip_atomic_load(ctr, __ATOMIC_RELAXED, __HIP_MEMORY_SCOPE_AGENT) < target) {
      __builtin_amdgcn_s_sleep(16);
      if (++spins > (1u << 24)) break;
    }
    __builtin_amdgcn_fence(__ATOMIC_ACQUIRE, "agent");
    asm volatile("s_waitcnt vmcnt(0)" ::: "memory");
  }
  __syncthreads();
}

__device__ __forceinline__ void gemm_tile_core(const bf16_t* A, int lda, const bf16_t* Wt,
                                               int ldw, int K, int m0, int n0, char* smem, bool tr,
                                               f32x16 (&acc)[2][2], int tid) {
  bf16_t* As = (bf16_t*)smem;
  bf16_t* Bs = As + 2 * 128 * 64;
  const int lane = tid & 63, w = tid >> 6, wr = w >> 1, wc = w & 1;
  const int lr = tid >> 3;
  const int lc = (((tid & 7) ^ ((tid >> 4) & 7))) * 8;
  const bf16_t* ga = A + (size_t)(m0 + lr) * lda + lc;
  const bf16_t* gb = Wt + (size_t)(n0 + lr) * ldw + lc;
#define GEMM_DMA(BUF, KOFF)                                                                                         \
  {                                                                                                                 \
    _Pragma("unroll") for (int i_ = 0; i_ < 4; ++i_) {                                                              \
      __builtin_amdgcn_global_load_lds((const unsigned*)(ga + (size_t)(32 * i_) * lda + (KOFF)),                    \
                                       (unsigned*)(As + (BUF) * 8192 + tid * 8 + i_ * 2048), 16, 0, 0);             \
      __builtin_amdgcn_global_load_lds((const unsigned*)(gb + (size_t)(32 * i_) * ldw + (KOFF)),                    \
                                       (unsigned*)(Bs + (BUF) * 8192 + tid * 8 + i_ * 2048), 16, 0, 0);             \
    }                                                                                                               \
  }
  GEMM_DMA(0, 0);
#pragma unroll
  for (int i = 0; i < 2; ++i)
#pragma unroll
    for (int j = 0; j < 2; ++j)
#pragma unroll
      for (int r = 0; r < 16; ++r) acc[i][j][r] = 0.f;
  asm volatile("s_waitcnt vmcnt(0)" ::: "memory");
  __syncthreads();
  const int nk = K >> 6;
  const int xr0 = ((tr ? wc : wr) * 64 + (lane & 31)) * 64;
  const int yr0 = ((tr ? wr : wc) * 64 + (lane & 31)) * 64;
  const int m7 = (lane >> 1) & 7, hh = lane >> 5;
  for (int kt = 0; kt < nk; ++kt) {
    const int cur = kt & 1;
    if (kt + 1 < nk) GEMM_DMA(cur ^ 1, (kt + 1) * 64);
    const bf16_t* Xs = (tr ? Bs : As) + cur * 8192 + xr0;
    const bf16_t* Ys = (tr ? As : Bs) + cur * 8192 + yr0;
    __builtin_amdgcn_s_setprio(1);
#pragma unroll
    for (int ks = 0; ks < 4; ++ks) {
      const int co = (((2 * ks + hh) ^ m7)) * 8;
      const bf8_t x0 = *(const bf8_t*)(Xs + co);
      const bf8_t x1 = *(const bf8_t*)(Xs + 32 * 64 + co);
      const bf8_t y0 = *(const bf8_t*)(Ys + co);
      const bf8_t y1 = *(const bf8_t*)(Ys + 32 * 64 + co);
      acc[0][0] = __builtin_amdgcn_mfma_f32_32x32x16_bf16(x0, y0, acc[0][0], 0, 0, 0);
      acc[0][1] = __builtin_amdgcn_mfma_f32_32x32x16_bf16(x0, y1, acc[0][1], 0, 0, 0);
      acc[1][0] = __builtin_amdgcn_mfma_f32_32x32x16_bf16(x1, y0, acc[1][0], 0, 0, 0);
      acc[1][1] = __builtin_amdgcn_mfma_f32_32x32x16_bf16(x1, y1, acc[1][1], 0, 0, 0);
    }
    __builtin_amdgcn_s_setprio(0);
    asm volatile("s_waitcnt vmcnt(0)" ::: "memory");
    __syncthreads();
  }
#undef GEMM_DMA
}

struct TileWalk {
  int m0, nrows, c0, ncols, t, step, count;
  __device__ __forceinline__ TileWalk(int MT, int NTL) {
    const int xcd = blockIdx.x & 7, xr = xcd >> 1, xc = xcd & 1;
    const int q = MT >> 2, rem = MT & 3;
    m0 = xr * q + (xr < rem ? xr : rem);
    nrows = q + (xr < rem ? 1 : 0);
    const int half = (NTL + 1) >> 1;
    c0 = xc ? half : 0;
    ncols = xc ? NTL - half : half;
    t = blockIdx.x >> 3;
    step = gridDim.x >> 3;
    count = nrows * ncols;
  }
  __device__ __forceinline__ bool valid() const { return t < count; }
  __device__ __forceinline__ void next() { t += step; }
  __device__ __forceinline__ int mt() const { return m0 + t / ncols; }
  __device__ __forceinline__ int nt() const { return c0 + t % ncols; }
};

struct GemmM { const bf16_t* A; int lda; const bf16_t* Wt; int ldw; int K; int mtiles; int ntiles; float* C; int ldc; int N; };
__device__ void mgemm_phase(const GemmM& g, char* smem, int wv) {
  const int tid = opaque_tid(wv);
  const int lane = tid & 63, w = tid >> 6, wr = w >> 1, wc = w & 1;
  for (int u = blockIdx.x; u < g.mtiles * g.ntiles; u += gridDim.x) {
    const int mt = u / g.ntiles, nt = u % g.ntiles;
    f32x16 acc[2][2];
    gemm_tile_core(g.A, g.lda, g.Wt, g.ldw, g.K, mt * 128, nt * 128, smem, false, acc, tid);
#pragma unroll
    for (int i = 0; i < 2; ++i)
#pragma unroll
      for (int j = 0; j < 2; ++j) {
        const int col = nt * 128 + wc * 64 + j * 32 + (lane & 31);
        if (col < g.N) {
#pragma unroll
          for (int r = 0; r < 16; ++r) {
            const int row = mt * 128 + wr * 64 + i * 32 + acc_row(r, lane);
            g.C[(size_t)row * g.ldc + col] = acc[i][j][r];
          }
        }
      }
  }
}

__device__ __forceinline__ int att_colmap(int n) {
  if (n < 256) return A_CQ + n;
  if (n < 384) return A_CKV + (n - 256);
  if (n < 896) return A_QB + (n - 384);
  if (n < 1024) return A_KB + (n - 896);
  if (n < 1152) return A_VB + (n - 1024);
  if (n < 1184) return A_KR + (n - 1152);
  if (n < 1216) return -1;
  if (n < 1728) return A_GA + (n - 1216);
  if (n < 2240) return A_GB + (n - 1728);
  return -1;
}
__device__ __forceinline__ int rec_colmap(int n) {
  if (n < 1536) return R_QKV + n;
  if (n < 2048) return R_Z + (n - 1536);
  if (n < 2560) return R_GR + (n - 2048);
  if (n < 3072) return R_XR + (n - 2560);
  if (n < 3088) return R_B + (n - 3072);
  return -1;
}
__device__ __forceinline__ int uq_colmap(int n) {
  if (n < 512) return (n >> 6) * 96 + (n & 63);
  const int e = n - 512;
  return (e >> 5) * 96 + 64 + (e & 31);
}
__device__ __forceinline__ int ukv_colmap(int n) {
  if (n < 512) return (n >> 6) * 128 + (n & 63);
  const int e = n - 512;
  return (e >> 6) * 128 + 64 + (e & 63);
}
__device__ __forceinline__ void wconv2_item(const float* src, int nsrc, int K, bf16_t* dst, int mode, const float* kscale,
                                            long i) {
  const int kgs = K >> 4;
  const int kg = (int)(i % kgs);
  const int n = (int)(i / kgs);
  int col = n;
  if (mode == 1) col = att_colmap(n);
  else if (mode == 2) col = uq_colmap(n);
  else if (mode == 3) col = ukv_colmap(n);
  else if (mode == 4) col = rec_colmap(n);
  if (col >= nsrc) col = -1;
  unsigned* d32 = (unsigned*)(dst + (size_t)n * K + kg * 16);
  unsigned zero = 0;
  asm volatile("" : "+v"(zero));
#pragma unroll
  for (int t = 0; t < 8; ++t) {
    unsigned lo = zero, hi = zero;
    if (col >= 0) {
      const int k0 = kg * 16 + 2 * t;
      float a = src[(size_t)k0 * nsrc + col], b = src[(size_t)(k0 + 1) * nsrc + col];
      if (kscale) { a *= kscale[k0]; b *= kscale[k0 + 1]; }
      lo = f2bf_dev(a); hi = f2bf_dev(b);
    }
    d32[t] = lo | (hi << 16);
  }
}
__device__ __forceinline__ void mod_item_dev(const Params& p, long i) {
  const int j = (int)(i % 3072);
  const int r = (int)((i / 3072) % MODROWS);
  const int l = (int)(i / (3072 * MODROWS));
  const float* cv = r < NB ? p.c + (size_t)r * D : p.c_ctx + 0;
  const float* w = p.mod_w + (size_t)l * D * 3072 + j;
  float acc = 0.f;
  for (int k = 0; k < D; ++k) acc += siluf_(cv[k]) * w[(size_t)k * 3072];
  ((float*)(p.ws + WsOff::modv))[i] = acc + p.mod_b[l * 3072 + j];
}
__device__ __forceinline__ void wconv_tile(const float* src, int nsrc, int K, bf16_t* dst, int mode, const float* kscale,
                                           int n0, int k0, char* smem, int tid) {
  bf16_t* T = (bf16_t*)smem;
  const int nn = tid & 63, kk = tid >> 6;
  const int n = n0 + nn;
  int col = n;
  if (mode == 1) col = att_colmap(n);
  else if (mode == 2) col = uq_colmap(n);
  else if (mode == 3) col = ukv_colmap(n);
  else if (mode == 4) col = rec_colmap(n);
  if (col >= nsrc) col = -1;
#pragma unroll 4
  for (int ps = 0; ps < 16; ++ps) {
    const int k = ps * 4 + kk;
    float v = 0.f;
    if (col >= 0) {
      v = src[(size_t)(k0 + k) * nsrc + col];
      if (kscale) v *= kscale[k0 + k];
    }
    T[nn * 66 + k] = f2bf_dev(v);
  }
  __syncthreads();
  {
    const int row = tid >> 2, part = tid & 3;
    const unsigned* t32 = (const unsigned*)(T + row * 66 + part * 16);
    uint4 a, b;
    a.x = t32[0]; a.y = t32[1]; a.z = t32[2]; a.w = t32[3];
    b.x = t32[4]; b.y = t32[5]; b.z = t32[6]; b.w = t32[7];
    bf16_t* d = dst + (size_t)(n0 + row) * K + k0 + part * 16;
    *(uint4*)d = a;
    *(uint4*)(d + 8) = b;
  }
  __syncthreads();
}
__device__ __forceinline__ int wconv_matrix(const float* src, int nsrc, int rows, int K, bf16_t* dst, int mode,
                                            const float* kscale, int u0, char* smem, int tid) {
  const int kt = K >> 6, nt = rows >> 6;
  const int total = kt * nt;
  int u = (int)blockIdx.x - (u0 % (int)gridDim.x);
  if (u < 0) u += gridDim.x;
  for (; u < total; u += gridDim.x) wconv_tile(src, nsrc, K, dst, mode, kscale, (u / kt) * 64, (u % kt) * 64, smem, tid);
  return u0 + total;
}
__device__ __forceinline__ void convert_outproj(const Params& p, int layer, char* smem, int tid) {
  const float* src = (layer & 1) == 0 ? p.att_w_out + (size_t)(layer >> 1) * D * D : p.rec_w_out + (size_t)(layer >> 1) * D * D;
  (void)wconv_matrix(src, D, D, D, ((bf16_t*)(p.ws + WsOff::WtIn)), 0, nullptr, 0, smem, tid);
}
__device__ void mod_phase(const Params& p, char* smem, int tid) {
  float* sc = (float*)smem;
  float* red = sc + MODROWS * 1024;
  for (int i = tid; i < MODROWS * 1024; i += 256) {
    const int r = i >> 10, k = i & 1023;
    const float c = r < NB ? p.c[(size_t)r * D + k] : p.c_ctx[k];
    sc[i] = c / (1.0f + __expf(-c));
  }
  __syncthreads();
  const int jj = tid & 31, kg = tid >> 5;
  for (int u = blockIdx.x; u < 4 * 96; u += gridDim.x) {
    const int l = u / 96, j = (u % 96) * 32 + jj;
    const float* w = p.mod_w + (size_t)l * D * 3072 + (size_t)(kg * 128) * 3072 + j;
    float acc[MODROWS];
#pragma unroll
    for (int r = 0; r < MODROWS; ++r) acc[r] = 0.f;
#pragma unroll 8
    for (int k = 0; k < 128; ++k) {
      const float wv_ = w[(size_t)k * 3072];
#pragma unroll
      for (int r = 0; r < MODROWS; ++r) acc[r] += sc[r * 1024 + kg * 128 + k] * wv_;
    }
#pragma unroll
    for (int r = 0; r < MODROWS; ++r) red[(kg * MODROWS + r) * 32 + jj] = acc[r];
    __syncthreads();
    if (tid < MODROWS * 32) {
      const int r = tid >> 5, c = tid & 31;
      float t = 0.f;
#pragma unroll
      for (int g = 0; g < 8; ++g) t += red[(g * MODROWS + r) * 32 + c];
      const int jo = (u % 96) * 32 + c;
      ((float*)(p.ws + WsOff::modv))[((size_t)l * MODROWS + r) * 3072 + jo] = t + p.mod_b[l * 3072 + jo];
    }
    __syncthreads();
  }
}

__device__ __forceinline__ void rope_table_item(const Params& p, int i) {
  if (i < 64 * 16) {
    const int pos = i >> 4, f = i & 15;
    const float ang = (float)pos * powf(10000.0f, -(float)(2 * f) / 32.0f);
    ((float*)(p.ws + WsOff::ropeG))[2 * i] = cosf(ang); ((float*)(p.ws + WsOff::ropeG))[2 * i + 1] = sinf(ang);
  } else {
    const int k = i - 64 * 16;
    const int pos = k >> 3, f = k & 7;
    const float ang = (float)pos * powf(10000.0f, -(float)(2 * f) / 16.0f);
    ((float*)(p.ws + WsOff::ropeM))[2 * k] = cosf(ang); ((float*)(p.ws + WsOff::ropeM))[2 * k + 1] = sinf(ang);
  }
}

__device__ __forceinline__ void store_T64(bf16_t* dstrow, const f32x16& a0, const f32x16& a1, int lane) {
  const int h4 = (lane >> 5) * 4;
#pragma unroll
  for (int q = 0; q < 4; ++q) {
    *(uint2*)(dstrow + 8 * q + h4) = pack4(a0[4 * q], a0[4 * q + 1], a0[4 * q + 2], a0[4 * q + 3]);
    *(uint2*)(dstrow + 32 + 8 * q + h4) = pack4(a1[4 * q], a1[4 * q + 1], a1[4 * q + 2], a1[4 * q + 3]);
  }
}
__device__ __forceinline__ float sumsq16(const f32x16& a) {
  float s = 0.f;
#pragma unroll
  for (int r = 0; r < 16; ++r) s += a[r] * a[r];
  return s;
}
__device__ __forceinline__ void rope_gqa(f32x16& a, const float* tab  , int lane) {
  const int h4 = (lane >> 5) * 4;
#pragma unroll
  for (int r = 0; r < 8; ++r) {
    const int i0 = (r & 3) + 8 * ((r >> 2) & 1) + h4;
    const float c = tab[2 * i0], s = tab[2 * i0 + 1];
    const float x1 = a[r], x2 = a[r + 8];
    a[r] = x1 * c - x2 * s;
    a[r + 8] = x1 * s + x2 * c;
  }
}
__device__ __forceinline__ void rope_mla(f32x16& a, const float* tabr  , const float* tabc, int lane) {
  const int h4 = (lane >> 5) * 4;
#pragma unroll
  for (int part = 0; part < 2; ++part) {
    const float* tab = part == 0 ? tabr : tabc;
#pragma unroll
    for (int e = 0; e < 4; ++e) {
      const int r = 8 * part + e;
      const int i0 = e + h4;
      const float c = tab[2 * i0], s = tab[2 * i0 + 1];
      const float x1 = a[r], x2 = a[r + 4];
      a[r] = x1 * c - x2 * s;
      a[r + 4] = x1 * s + x2 * c;
    }
  }
}

__device__ void att_inproj_phase(const Params& p_, int layer, char* smem, int wv) {
  const Params p = phase_params(p_);
  const int li = layer >> 1;
  const int tid = opaque_tid(wv);
  const int lane = tid & 63, w = tid >> 6, wr = w >> 1, wc = w & 1;
  const bf16_t* Wt = ((bf16_t*)(p.ws + WsOff::WtIn));
  constexpr int MT = NALL / 128, NTL = ATT_NPAD / 128;
  for (TileWalk tw(MT, NTL); tw.valid(); tw.next()) {
    const int mt = tw.mt(), nt = tw.nt();
    const int slab = 2 * nt + wc;
    const bool tr = slab < 19;
    f32x16 acc[2][2];
    gemm_tile_core(((bf16_t*)(p.ws + WsOff::H)), D, Wt, D, D, mt * 128, nt * 128, smem, tr, acc, tid);
    const int mbase = mt * 128 + wr * 64;
    const int b = (mt * 128) / NT;
    const int lt0 = mt * 128 - b * NT + wr * 64;
    const bool lat = lt0 < SEQ;
    if (slab < 6) {
#pragma unroll
      for (int j = 0; j < 2; ++j) {
        const int gt = mbase + j * 32 + (lane & 31);
        float ss = sumsq16(acc[0][j]) + sumsq16(acc[1][j]);
        ss += __shfl_xor(ss, 32);
        bf16_t* dst = slab < 4 ? ((bf16_t*)(p.ws + WsOff::CQ)) + (size_t)gt * 256 + slab * 64 : ((bf16_t*)(p.ws + WsOff::CKV)) + (size_t)gt * 128 + (slab - 4) * 64;
        store_T64(dst, acc[0][j], acc[1][j], lane);
        if (lane < 32) {
          if (slab < 4) ((float*)(p.ws + WsOff::sqq))[(size_t)gt * 4 + slab] = ss;
          else ((float*)(p.ws + WsOff::sqkv))[(size_t)gt * 2 + (slab - 4)] = ss;
        }
      }
    } else if (slab < 16) {
      const bool isq = slab < 14;
      const int head = isq ? slab - 6 : slab - 14;
      const float* nw = (isq ? p.gqa_q_norm + 0 : p.gqa_k_norm + 0) + li * 64;
      const float post = isq ? 0.125f * LOG2E : 1.0f;
#pragma unroll
      for (int j = 0; j < 2; ++j) {
        const int gt = mbase + j * 32 + (lane & 31);
        const int lt = lt0 + j * 32 + (lane & 31);
        float ss = sumsq16(acc[0][j]) + sumsq16(acc[1][j]);
        ss += __shfl_xor(ss, 32);
        const float rinv = rsqrtf(ss * (1.0f / 64.0f) + EPS) * post;
#pragma unroll
        for (int i = 0; i < 2; ++i)
#pragma unroll
          for (int r = 0; r < 16; ++r) acc[i][j][r] *= rinv * nw[i * 32 + acc_row(r, lane)];
        if (lat) {
          rope_gqa(acc[0][j], ((float*)(p.ws + WsOff::ropeG)) + (lt >> 6) * 32, lane);
          rope_gqa(acc[1][j], ((float*)(p.ws + WsOff::ropeG)) + (lt & 63) * 32, lane);
        }
        bf16_t* dst = isq ? ((bf16_t*)(p.ws + WsOff::QG)) + (size_t)gt * 512 + head * 64 : ((bf16_t*)(p.ws + WsOff::KG)) + (size_t)gt * 128 + head * 64;
        store_T64(dst, acc[0][j], acc[1][j], lane);
      }
    } else if (slab < 18) {
      const int kvh = slab - 16;
#pragma unroll
      for (int j = 0; j < 2; ++j) {
        const int lt = lt0 + j * 32 + (lane & 31);
        bf16_t* dst = ((bf16_t*)(p.ws + WsOff::VTG)) + ((size_t)(b * 2 + kvh) * 64) * NT + lt;
#pragma unroll
        for (int i = 0; i < 2; ++i)
#pragma unroll
          for (int r = 0; r < 16; ++r) dst[(size_t)(i * 32 + acc_row(r, lane)) * NT] = f2bf_dev(acc[i][j][r]);
      }
    } else if (slab == 18) {
#pragma unroll
      for (int j = 0; j < 2; ++j) {
        const int gt = mbase + j * 32 + (lane & 31);
        const int lt = lt0 + j * 32 + (lane & 31);
        if (lat) rope_mla(acc[0][j], ((float*)(p.ws + WsOff::ropeM)) + (lt >> 6) * 16, ((float*)(p.ws + WsOff::ropeM)) + (lt & 63) * 16, lane);
        bf16_t* dst = ((bf16_t*)(p.ws + WsOff::KRb)) + (size_t)gt * 32 + (lane >> 5) * 4;
#pragma unroll
        for (int q = 0; q < 4; ++q)
          *(uint2*)(dst + 8 * q) = pack4(acc[0][j][4 * q], acc[0][j][4 * q + 1], acc[0][j][4 * q + 2], acc[0][j][4 * q + 3]);
      }
    } else if (slab < 35) {
      const int cbase = (slab - 19) * 64;
#pragma unroll
      for (int i = 0; i < 2; ++i)
#pragma unroll
        for (int j = 0; j < 2; ++j)
#pragma unroll
          for (int r = 0; r < 16; ++r) {
            const int gt = mbase + i * 32 + acc_row(r, lane);
            ((bf16_t*)(p.ws + WsOff::GAB))[(size_t)gt * 1024 + cbase + j * 32 + (lane & 31)] = f2bf_dev(acc[i][j][r]);
          }
    }
  }
}

__device__ void upproj_phase(const Params& p_, int layer, char* smem, int wv) {
  const Params p = phase_params(p_);
  convert_outproj(p, layer, smem, opaque_tid(wv));
  const int li = layer >> 1;
  const int tid = opaque_tid(wv);
  const int lane = tid & 63, w = tid >> 6, wr = w >> 1, wc = w & 1;
  constexpr int MT = NALL / 128;
  constexpr int NTQ = 768 / 128, NTKV = 1024 / 128;
  const bf16_t* Wq = ((bf16_t*)(p.ws + WsOff::Wuq)) + (size_t)li * 768 * 256;
  const bf16_t* Wkv = ((bf16_t*)(p.ws + WsOff::Wukv)) + (size_t)li * 1024 * 128;
  const float qscale = 0.10206207261596575f * LOG2E;
  for (TileWalk tw(MT, NTQ + NTKV); tw.valid(); tw.next()) {
    const int mt = tw.mt();
    int nt = tw.nt();
    const bool isq = nt < NTQ;
    if (!isq) nt -= NTQ;
    const int slab = 2 * nt + wc;
    const bool tr = slab >= 8;
    f32x16 acc[2][2];
    if (isq) gemm_tile_core(((bf16_t*)(p.ws + WsOff::CQ)), 256, Wq, 256, 256, mt * 128, nt * 128, smem, tr, acc, tid);
    else gemm_tile_core(((bf16_t*)(p.ws + WsOff::CKV)), 128, Wkv, 128, 128, mt * 128, nt * 128, smem, tr, acc, tid);
    const int mbase = mt * 128 + wr * 64;
    const int b = (mt * 128) / NT;
    const int lt0 = mt * 128 - b * NT + wr * 64;
    const bool lat = lt0 < SEQ;
    if (!tr) {
      bf16_t* dstb = (isq ? ((bf16_t*)(p.ws + WsOff::QN)) + 0 : ((bf16_t*)(p.ws + WsOff::KN)) + 0) + slab * 64;
#pragma unroll
      for (int i = 0; i < 2; ++i)
#pragma unroll
        for (int r = 0; r < 16; ++r) {
          const int gt = mbase + i * 32 + acc_row(r, lane);
          float rs;
          if (isq) {
            const float4 sq = *(const float4*)(((float*)(p.ws + WsOff::sqq)) + (size_t)gt * 4);
            rs = rsqrtf((sq.x + sq.y + sq.z + sq.w) * (1.0f / 256.0f) + EPS) * qscale;
          } else {
            const float2 sq = *(const float2*)(((float*)(p.ws + WsOff::sqkv)) + (size_t)gt * 2);
            rs = rsqrtf((sq.x + sq.y) * (1.0f / 128.0f) + EPS);
          }
#pragma unroll
          for (int j = 0; j < 2; ++j)
            dstb[(size_t)gt * 512 + j * 32 + (lane & 31)] = f2bf_dev(acc[i][j][r] * rs);
        }
    } else {
#pragma unroll
      for (int j = 0; j < 2; ++j) {
        const int gt = mbase + j * 32 + (lane & 31);
        const int lt = lt0 + j * 32 + (lane & 31);
        if (isq) {
          const float4 sq = *(const float4*)(((float*)(p.ws + WsOff::sqq)) + (size_t)gt * 4);
          const float rs = rsqrtf((sq.x + sq.y + sq.z + sq.w) * (1.0f / 256.0f) + EPS) * qscale;
#pragma unroll
          for (int i = 0; i < 2; ++i) {
#pragma unroll
            for (int r = 0; r < 16; ++r) acc[i][j][r] *= rs;
            if (lat) rope_mla(acc[i][j], ((float*)(p.ws + WsOff::ropeM)) + (lt >> 6) * 16, ((float*)(p.ws + WsOff::ropeM)) + (lt & 63) * 16, lane);
          }
          store_T64(((bf16_t*)(p.ws + WsOff::QR)) + (size_t)gt * 256 + (slab - 8) * 64, acc[0][j], acc[1][j], lane);
        } else {
          const float2 sq = *(const float2*)(((float*)(p.ws + WsOff::sqkv)) + (size_t)gt * 2);
          const float rs = rsqrtf((sq.x + sq.y) * (1.0f / 128.0f) + EPS);
          bf16_t* dst = ((bf16_t*)(p.ws + WsOff::VTA)) + ((size_t)(b * 8 + (slab - 8)) * 64) * NT + lt;
#pragma unroll
          for (int i = 0; i < 2; ++i)
#pragma unroll
            for (int r = 0; r < 16; ++r) dst[(size_t)(i * 32 + acc_row(r, lane)) * NT] = f2bf_dev(acc[i][j][r] * rs);
        }
      }
    }
  }
}

struct AttnUnit {
  unsigned q0, q0rb;
  unsigned q1, q1rb;
  unsigned k0, k0rb;
  unsigned k1, k1rb;
  unsigned vt;
  unsigned gate, out;
  int gt_base;
  int kt0, kt1;
  int qlt;
  int tid;
};

__device__ __forceinline__ int swap23(int r) { return (r & ~12) | ((r & 4) << 1) | ((r & 8) >> 1); }
__device__ __forceinline__ float max3f(float a, float b, float c) {
  float r;
  asm("v_max3_f32 %0, %1, %2, %3" : "=v"(r) : "v"(a), "v"(b), "v"(c));
  return r;
}
typedef __attribute__((ext_vector_type(2))) float f32x2;

template <int DQK>
__device__ __forceinline__ void attention_unit(const AttnUnit& a, const char* ws, char* smem) {
  constexpr int KLD = DQK + 8;
  constexpr int VLD = 72;
  constexpr int KCH = DQK / 8;
  bf16_t* Ks = (bf16_t*)smem;
  bf16_t* Vs = Ks + 2 * 64 * KLD;
  const int tid = a.tid, lane = tid & 63;
  const int r31 = lane & 31, h8 = (lane >> 5) * 8;
  bf8_t qf[DQK / 16];
  {
    const unsigned gq = (unsigned)(a.gt_base + a.qlt);
#pragma unroll
    for (int s = 0; s < DQK / 16; ++s) {
      const int d0 = 16 * s + h8;
      if (s < 4) qf[s] = *(const bf8_t*)(ws + a.q0 + gq * a.q0rb + d0 * 2);
      else qf[s] = *(const bf8_t*)(ws + a.q1 + gq * a.q1rb + (d0 - 64) * 2);
    }
  }
  unsigned gk0, gk1, gk2 = 0, ik0, ik1, ik2 = 0, gv0, gv1;
  int lk0, lk1, lk2 = 0, lv0, lv1;
  {
    const unsigned g0 = (unsigned)(a.gt_base + a.kt0 * 64);
#define ATT_KSETUP(C_, GK, IK, LK)                                                              \
    {                                                                                             \
      const int id = tid + 256 * C_;                                                              \
      const int key = id / KCH, part = id % KCH;                                                  \
      const bool hi = DQK == 96 && part >= 8;                                                     \
      GK = hi ? a.k1 + (g0 + key) * a.k1rb + (part - 8) * 16 : a.k0 + (g0 + key) * a.k0rb + part * 16; \
      IK = 64u * (hi ? a.k1rb : a.k0rb);                                                          \
      LK = key * KLD + part * 8;                                                                  \
    }
    ATT_KSETUP(0, gk0, ik0, lk0)
    ATT_KSETUP(1, gk1, ik1, lk1)
    if (DQK == 96) ATT_KSETUP(2, gk2, ik2, lk2)
#undef ATT_KSETUP
    const int dvA = tid >> 3, part = tid & 7;
    gv0 = a.vt + (unsigned)dvA * (NT * 2) + (unsigned)(a.kt0 * 64) * 2 + part * 16;
    gv1 = gv0 + 32u * (NT * 2);
    lv0 = dvA * VLD + part * 8;
    lv1 = lv0 + 32 * VLD;
  }
  uint4 rk0, rk1, rk2 = make_uint4(0, 0, 0, 0), rv0, rv1;
#define ATT_LOAD()                                                                                \
  {                                                                                               \
    rk0 = *(const uint4*)(ws + gk0); rk1 = *(const uint4*)(ws + gk1);                             \
    if (DQK == 96) rk2 = *(const uint4*)(ws + gk2);                                               \
    rv0 = *(const uint4*)(ws + gv0); rv1 = *(const uint4*)(ws + gv1);                             \
    gk0 += ik0; gk1 += ik1; gk2 += ik2; gv0 += 128u; gv1 += 128u;                                 \
  }
#define ATT_STORE(BUF)                                                                            \
  {                                                                                               \
    *(uint4*)(Ks + (BUF) * 64 * KLD + lk0) = rk0; *(uint4*)(Ks + (BUF) * 64 * KLD + lk1) = rk1;   \
    if (DQK == 96) *(uint4*)(Ks + (BUF) * 64 * KLD + lk2) = rk2;                                  \
    *(uint4*)(Vs + (BUF) * 64 * VLD + lv0) = rv0; *(uint4*)(Vs + (BUF) * 64 * VLD + lv1) = rv1;   \
  }
  ATT_LOAD();
  ATT_STORE(0);
  __syncthreads();
#pragma unroll
  for (int s = 0; s < DQK / 16; ++s) asm volatile("" :: "v"(qf[s]));
  f32x16 o0, o1, negm;
#pragma unroll
  for (int r = 0; r < 16; ++r) { o0[r] = 0.f; o1[r] = 0.f; negm[r] = 0.f; }
  float l = 0.f;
  bool first = true;
  const int krow = swap23(r31) * KLD + h8;
  const int vrow = r31 * VLD + h8;
  for (int kt = a.kt0; kt < a.kt1; ++kt) {
    const int cur = (kt - a.kt0) & 1;
    if (kt + 1 < a.kt1) ATT_LOAD();
    asm volatile("" ::: "memory");
    __builtin_amdgcn_sched_barrier(0);
    const bf16_t* Kc = Ks + cur * 64 * KLD + krow;
    const bf16_t* Vc = Vs + cur * 64 * VLD + vrow;
    f32x16 s0, s1;
    {
      const bf8_t k0 = *(const bf8_t*)(Kc);
      const bf8_t k1 = *(const bf8_t*)(Kc + 32 * KLD);
      s0 = __builtin_amdgcn_mfma_f32_32x32x16_bf16(k0, qf[0], negm, 0, 0, 0);
      s1 = __builtin_amdgcn_mfma_f32_32x32x16_bf16(k1, qf[0], negm, 0, 0, 0);
    }
#pragma unroll
    for (int ks = 1; ks < DQK / 16; ++ks) {
      const bf8_t k0 = *(const bf8_t*)(Kc + ks * 16);
      const bf8_t k1 = *(const bf8_t*)(Kc + 32 * KLD + ks * 16);
      s0 = __builtin_amdgcn_mfma_f32_32x32x16_bf16(k0, qf[ks], s0, 0, 0, 0);
      s1 = __builtin_amdgcn_mfma_f32_32x32x16_bf16(k1, qf[ks], s1, 0, 0, 0);
    }
    float mx = max3f(s0[0], s1[0], s0[1]);
    mx = max3f(mx, s1[1], s0[2]);
#pragma unroll
    for (int r = 2; r < 15; ++r) mx = max3f(mx, s1[r], s0[r + 1]);
    mx = fmaxf(mx, s1[15]);
    mx = fmaxf(mx, __shfl_xor(mx, 32));
    if (first || __builtin_amdgcn_ballot_w64(mx > 4.0f) != 0ull) {
      const float d = first ? mx : fmaxf(mx, 0.f);
      const float alpha = first ? 0.f : __builtin_amdgcn_exp2f(-d);
      first = false;
      l *= alpha;
#pragma unroll
      for (int r = 0; r < 16; ++r) { o0[r] *= alpha; o1[r] *= alpha; negm[r] -= d; s0[r] -= d; s1[r] -= d; }
    }
    f32x2 ps2 = {0.f, 0.f};
#pragma unroll
    for (int r = 0; r < 16; ++r) {
      s0[r] = __builtin_amdgcn_exp2f(s0[r]);
      s1[r] = __builtin_amdgcn_exp2f(s1[r]);
      f32x2 t = {s0[r], s1[r]};
      ps2 += t;
    }
    l += ps2[0] + ps2[1];
    {
      bf8_t p00, p01, p10, p11;
#pragma unroll
      for (int e = 0; e < 8; ++e) {
        p00[e] = (__bf16)s0[e]; p01[e] = (__bf16)s0[8 + e];
        p10[e] = (__bf16)s1[e]; p11[e] = (__bf16)s1[8 + e];
      }
      const bf8_t v000 = *(const bf8_t*)(Vc);
      const bf8_t v001 = *(const bf8_t*)(Vc + 16);
      const bf8_t v010 = *(const bf8_t*)(Vc + 32);
      const bf8_t v011 = *(const bf8_t*)(Vc + 48);
      const bf8_t v100 = *(const bf8_t*)(Vc + 32 * VLD);
      const bf8_t v101 = *(const bf8_t*)(Vc + 32 * VLD + 16);
      const bf8_t v110 = *(const bf8_t*)(Vc + 32 * VLD + 32);
      const bf8_t v111 = *(const bf8_t*)(Vc + 32 * VLD + 48);
      o0 = __builtin_amdgcn_mfma_f32_32x32x16_bf16(v000, p00, o0, 0, 0, 0);
      o1 = __builtin_amdgcn_mfma_f32_32x32x16_bf16(v100, p00, o1, 0, 0, 0);
      o0 = __builtin_amdgcn_mfma_f32_32x32x16_bf16(v001, p01, o0, 0, 0, 0);
      o1 = __builtin_amdgcn_mfma_f32_32x32x16_bf16(v101, p01, o1, 0, 0, 0);
      o0 = __builtin_amdgcn_mfma_f32_32x32x16_bf16(v010, p10, o0, 0, 0, 0);
      o1 = __builtin_amdgcn_mfma_f32_32x32x16_bf16(v110, p10, o1, 0, 0, 0);
      o0 = __builtin_amdgcn_mfma_f32_32x32x16_bf16(v011, p11, o0, 0, 0, 0);
      o1 = __builtin_amdgcn_mfma_f32_32x32x16_bf16(v111, p11, o1, 0, 0, 0);
    }
    __builtin_amdgcn_sched_barrier(0);
    if (kt + 1 < a.kt1) ATT_STORE(cur ^ 1);
    __syncthreads();
  }
#undef ATT_LOAD
#undef ATT_STORE
  l += __shfl_xor(l, 32);
  const float inv = 1.0f / l;
  const unsigned gq = (unsigned)(a.gt_base + a.qlt);
  const bf16_t* gp = (const bf16_t*)(ws + a.gate + gq * 2048u) + (lane >> 5) * 4;
  bf16_t* op = (bf16_t*)(const_cast<char*>(ws) + a.out + gq * 2048u) + (lane >> 5) * 4;
#pragma unroll
  for (int q = 0; q < 4; ++q) {
    const uint2 g0 = *(const uint2*)(gp + 8 * q);
    const uint2 g1 = *(const uint2*)(gp + 32 + 8 * q);
    *(uint2*)(op + 8 * q) = pack4(o0[4 * q] * inv * silu_fast(bf2f((bf16_t)(g0.x & 0xffff))),
                                  o0[4 * q + 1] * inv * silu_fast(bf2f((bf16_t)(g0.x >> 16))),
                                  o0[4 * q + 2] * inv * silu_fast(bf2f((bf16_t)(g0.y & 0xffff))),
                                  o0[4 * q + 3] * inv * silu_fast(bf2f((bf16_t)(g0.y >> 16))));
    *(uint2*)(op + 32 + 8 * q) = pack4(o1[4 * q] * inv * silu_fast(bf2f((bf16_t)(g1.x & 0xffff))),
                                       o1[4 * q + 1] * inv * silu_fast(bf2f((bf16_t)(g1.x >> 16))),
                                       o1[4 * q + 2] * inv * silu_fast(bf2f((bf16_t)(g1.y & 0xffff))),
                                       o1[4 * q + 3] * inv * silu_fast(bf2f((bf16_t)(g1.y >> 16))));
  }
}

template <int ABL>
__device__ void attention_phase(const Params& p_, char* smem, int wv) {
  const Params p = phase_params(p_);
  const int tid = opaque_tid(wv);
  const int lane = tid & 63, w = tid >> 6;
  constexpr int U_ML = NB * 8 * (SEQ / 128), U_GL = NB * 2 * (SEQ / 32);
  constexpr int U_MC = NB * 8 * (CTX / 128), U_GC = NB * 2 * (CTX / 32);
  constexpr int KT_ALL = NT / 64, KT_LAT = SEQ / 64;
  for (int u = blockIdx.x; u < U_ML + U_GL + U_MC + U_GC; u += gridDim.x) {
    AttnUnit a;
    a.tid = tid;
    a.kt1 = KT_ALL;
    if (u < U_ML || (u >= U_ML + U_GL && u < U_ML + U_GL + U_MC)) {
      const bool ctxq = u >= U_ML;
      const int v = ctxq ? u - (U_ML + U_GL) : u;
      const int nqb = ctxq ? CTX / 128 : SEQ / 128;
      const int qb = v % nqb, h = (v / nqb) & 7, b = v / (nqb * 8);
      a.q0 = (unsigned)WsOff::QN + h * 128; a.q0rb = 1024; a.q1 = (unsigned)WsOff::QR + h * 64; a.q1rb = 512;
      a.k0 = (unsigned)WsOff::KN + h * 128; a.k0rb = 1024; a.k1 = (unsigned)WsOff::KRb; a.k1rb = 64;
      a.vt = (unsigned)WsOff::VTA + (unsigned)((b * 8 + h) * 64) * (NT * 2);
      a.gt_base = b * NT;
      a.kt0 = ctxq ? KT_LAT : 0;
      a.qlt = (ctxq ? SEQ : 0) + qb * 128 + w * 32 + (lane & 31);
      a.gate = (unsigned)WsOff::GAB + h * 128; a.out = (unsigned)(ABL ? WsOff::H : WsOff::mixh) + h * 128;
      if (ABL != 6) attention_unit<96>(a, p.ws, smem);
    } else {
      const bool ctxq = u >= U_ML + U_GL;
      const int v = ctxq ? u - (U_ML + U_GL + U_MC) : u - U_ML;
      const int nqb = ctxq ? CTX / 32 : SEQ / 32;
      const int qb = v % nqb, kvh = (v / nqb) & 1, b = v / (nqb * 2);
      const int hq = kvh * 4 + w;
      a.q0 = (unsigned)WsOff::QG + hq * 128; a.q0rb = 1024; a.q1 = a.q0; a.q1rb = 1024;
      a.k0 = (unsigned)WsOff::KG + kvh * 128; a.k0rb = 256; a.k1 = a.k0; a.k1rb = 256;
      a.vt = (unsigned)WsOff::VTG + (unsigned)((b * 2 + kvh) * 64) * (NT * 2);
      a.gt_base = b * NT;
      a.kt0 = ctxq ? KT_LAT : 0;
      a.qlt = (ctxq ? SEQ : 0) + qb * 32 + (lane & 31);
      a.gate = (unsigned)WsOff::GAB + 1024 + hq * 128; a.out = (unsigned)(ABL ? WsOff::H : WsOff::mixh) + 1024 + hq * 128;
      if (ABL != 5) attention_unit<64>(a, p.ws, smem);
    }
  }
}

template <bool DUMMY>
__device__ void outproj_phase(const Params& p_, int layer, char* smem, int wv) {
  const Params p = phase_params(p_);
  const int tid = opaque_tid(wv);
  const int lane = tid & 63, w = tid >> 6, wr = w >> 1, wc = w & 1;
  const bf16_t* Wt = ((bf16_t*)(p.ws + WsOff::WtIn));
  const bool last = layer == 3;
  constexpr int NTL = D / 128;
  const int mtiles = NALL / 128;
  for (TileWalk tw(mtiles, NTL); tw.valid(); tw.next()) {
    const int mt = tw.mt(), nt = tw.nt();
    const int b = (mt * 128) / NT;
    const int ltile = mt * 128 - b * NT;
    const bool lat = ltile < SEQ;
    if (last && !lat) continue;
    f32x16 acc[2][2];
    gemm_tile_core(((bf16_t*)(p.ws + WsOff::mixh)), D, Wt, D, D, mt * 128, nt * 128, smem, true, acc, tid);
    const float* xin = lat ? (layer == 0 ? p.x + 0 : p.out + 0) + ((size_t)b * SEQ + ltile) * D
                           : (layer == 0 ? p.ctx + 0 : ((float*)(p.ws + WsOff::Xctx)) + 0) + ((size_t)b * CTX + (ltile - SEQ)) * D;
    float* xout = DUMMY ? (float*)((bf16_t*)(p.ws + WsOff::CQ)) + (size_t)(mt * 128) * D
                        : (lat ? p.out + ((size_t)b * SEQ + ltile) * D : ((float*)(p.ws + WsOff::Xctx)) + ((size_t)b * CTX + (ltile - SEQ)) * D);
    const int c0 = nt * 128 + wc * 64 + (lane >> 5) * 4;
    const float* gate = ((float*)(p.ws + WsOff::modv)) + ((size_t)layer * MODROWS + (lat ? b : NB)) * 3072 + 2048 + c0;
    const float* lg = p.ln_g + (layer > 0 ? layer - 1 : 0) * D + c0;
    const float* lb = p.ln_b + (layer > 0 ? layer - 1 : 0) * D + c0;
#pragma unroll
    for (int j = 0; j < 2; ++j) {
      const int rloc = wr * 64 + j * 32 + (lane & 31);
      const size_t ro = (size_t)rloc * D + c0;
      float mu = 0.f, rstd = 1.0f;
      if (layer > 0) { const float2 st = *(const float2*)(((float*)(p.ws + WsOff::LNS)) + (size_t)(mt * 128 + rloc) * 2); mu = st.x; rstd = st.y; }
#pragma unroll
      for (int i = 0; i < 2; ++i)
#pragma unroll
        for (int q = 0; q < 4; ++q) {
          float4 xv = *(const float4*)(xin + ro + 32 * i + 8 * q);
          if (layer > 0) {
            const float4 g4 = *(const float4*)(lg + 32 * i + 8 * q);
            const float4 b4 = *(const float4*)(lb + 32 * i + 8 * q);
            xv.x = (xv.x - mu) * rstd * g4.x + b4.x; xv.y = (xv.y - mu) * rstd * g4.y + b4.y;
            xv.z = (xv.z - mu) * rstd * g4.z + b4.z; xv.w = (xv.w - mu) * rstd * g4.w + b4.w;
          }
          const float4 gv = *(const float4*)(gate + 32 * i + 8 * q);
          float4 o;
          o.x = DN_ALPHA * xv.x + gv.x * acc[i][j][4 * q];
          o.y = DN_ALPHA * xv.y + gv.y * acc[i][j][4 * q + 1];
          o.z = DN_ALPHA * xv.z + gv.z * acc[i][j][4 * q + 2];
          o.w = DN_ALPHA * xv.w + gv.w * acc[i][j][4 * q + 3];
          *(float4*)(xout + ro + 32 * i + 8 * q) = o;
        }
    }
  }
}

template <bool DUMMY>
__device__ void ln_phase(const Params& p_, int layer, int wv) {
  const Params p = phase_params(p_);
  const int tid = opaque_tid(wv);
  const int lane = tid & 63;
  const int gw = (blockIdx.x * blockDim.x + tid) >> 6;
  const int nw = (gridDim.x * blockDim.x) >> 6;
  const bool last = layer == 3;
  const float* g = p.ln_g + layer * D;
  const float* bb = p.ln_b + layer * D;
  for (int gt = gw; gt < NALL; gt += nw) {
    const int b = gt / NT, lt = gt - b * NT;
    const bool lat = lt < SEQ;
    if (last && !lat) continue;
    float* xr = lat ? p.out + ((size_t)b * SEQ + lt) * D : ((float*)(p.ws + WsOff::Xctx)) + ((size_t)b * CTX + (lt - SEQ)) * D;
    float4 v[4];
    float s = 0.f;
#pragma unroll
    for (int k = 0; k < 4; ++k) {
      v[k] = *(const float4*)(xr + k * 256 + lane * 4);
      s += v[k].x + v[k].y + v[k].z + v[k].w;
    }
#pragma unroll
    for (int o = 32; o > 0; o >>= 1) s += __shfl_xor(s, o);
    const float mu = s * (1.0f / D);
    float q = 0.f;
#pragma unroll
    for (int k = 0; k < 4; ++k) {
      v[k].x -= mu; v[k].y -= mu; v[k].z -= mu; v[k].w -= mu;
      q += v[k].x * v[k].x + v[k].y * v[k].y + v[k].z * v[k].z + v[k].w * v[k].w;
    }
#pragma unroll
    for (int o = 32; o > 0; o >>= 1) q += __shfl_xor(q, o);
    const float rstd = rsqrtf(q * (1.0f / D) + EPS);
    if (!DUMMY && lane == 0) *(float2*)(((float*)(p.ws + WsOff::LNS)) + (size_t)gt * 2) = make_float2(mu, rstd);
    const float* modn = last ? nullptr : ((float*)(p.ws + WsOff::modv)) + ((size_t)(layer + 1) * MODROWS + (lat ? b : NB)) * 3072;
#pragma unroll
    for (int k = 0; k < 4; ++k) {
      const int c = k * 256 + lane * 4;
      const float4 gg = *(const float4*)(g + c);
      const float4 be = *(const float4*)(bb + c);
      float4 o;
      o.x = v[k].x * rstd * gg.x + be.x; o.y = v[k].y * rstd * gg.y + be.y;
      o.z = v[k].z * rstd * gg.z + be.z; o.w = v[k].w * rstd * gg.w + be.w;
      if (last) *(float4*)((DUMMY ? (float*)((bf16_t*)(p.ws + WsOff::CQ)) + (size_t)gt * D : xr) + c) = o;
      if (!last) {
        const float4 sh = *(const float4*)(modn + c);
        const float4 sc = *(const float4*)(modn + 1024 + c);
        *(uint2*)((DUMMY ? ((bf16_t*)(p.ws + WsOff::QN)) : ((bf16_t*)(p.ws + WsOff::H))) + (size_t)gt * D + c) = pack4(o.x * (1.0f + sc.x) + sh.x, o.y * (1.0f + sc.y) + sh.y,
                                                    o.z * (1.0f + sc.z) + sh.z, o.w * (1.0f + sc.w) + sh.w);
      }
    }
  }
}


__device__ __forceinline__ float sigmoid_fast(float x) { return 1.0f / (1.0f + __expf(-x)); }

__device__ void rec_inproj_phase(const Params& p_, char* smem, int wv) {
  const Params p = phase_params(p_);
  const int tid = opaque_tid(wv);
  const int lane = tid & 63, w = tid >> 6, wr = w >> 1, wc = w & 1;
  constexpr int MT = NALL / 128, NTL = REC_NPAD / 128;
  for (TileWalk tw(MT, NTL); tw.valid(); tw.next()) {
    const int mt = tw.mt(), nt = tw.nt();
    const int slab = 2 * nt + wc;
    f32x16 acc[2][2];
#ifndef REP_CORE
#define REP_CORE 1
#endif
    for (int rc = 0; rc < REP_CORE; ++rc) gemm_tile_core(((bf16_t*)(p.ws + WsOff::H)), D, ((bf16_t*)(p.ws + WsOff::WtIn)), D, D, mt * 128, nt * 128, smem, false, acc, tid);
    const int mbase = mt * 128 + wr * 64;
    if (slab < 48) {
      bf16_t* dst; int ld;
      if (slab < 24) { dst = ((bf16_t*)(p.ws + WsOff::PQKV)) + slab * 64; ld = 1536; }
      else if (slab < 40) { dst = ((bf16_t*)(p.ws + WsOff::PZG)) + (slab - 24) * 64; ld = 1024; }
      else { dst = ((bf16_t*)(p.ws + WsOff::PXR)) + (slab - 40) * 64; ld = 512; }
#pragma unroll
      for (int i = 0; i < 2; ++i)
#pragma unroll
        for (int j = 0; j < 2; ++j)
#pragma unroll
          for (int r = 0; r < 16; ++r) {
            const int gt = mbase + i * 32 + acc_row(r, lane);
            dst[(size_t)gt * ld + j * 32 + (lane & 31)] = f2bf_dev(acc[i][j][r]);
          }
    } else if (slab == 48) {
      if ((lane & 31) < 16) {
#pragma unroll
        for (int i = 0; i < 2; ++i)
#pragma unroll
          for (int r = 0; r < 16; ++r) {
            const int gt = mbase + i * 32 + acc_row(r, lane);
            ((float*)(p.ws + WsOff::PBA))[(size_t)gt * 16 + (lane & 31)] = acc[i][0][r];
          }
      }
    }
  }
}

template <int I>
struct FwdSub {
  static __device__ __forceinline__ void run(const float* M, float (&t)[64], int c) {
    FwdSub<I - 1>::run(M, t, c);
    float a0 = (I == c) ? 1.0f : 0.0f, a1 = 0.f, a2 = 0.f, a3 = 0.f;
    const float* row = M + I * 64;
#pragma unroll
    for (int j4 = 0; j4 < (I + 3) / 4; ++j4) {
      const float4 m = *(const float4*)(row + 4 * j4);
      if (4 * j4 + 0 < I) a0 -= m.x * t[4 * j4 + 0];
      if (4 * j4 + 1 < I) a1 -= m.y * t[4 * j4 + 1];
      if (4 * j4 + 2 < I) a2 -= m.z * t[4 * j4 + 2];
      if (4 * j4 + 3 < I) a3 -= m.w * t[4 * j4 + 3];
    }
    t[I] = (a0 + a1) + (a2 + a3);
  }
};
template <>
struct FwdSub<-1> {
  static __device__ __forceinline__ void run(const float*, float (&)[64], int) {}
};

#ifndef FWD_PACKED
#define FWD_PACKED 0
#endif
#ifndef SCAN_RAW_BAR
#define SCAN_RAW_BAR 0
#endif
__device__ void gdn_chunk_unit(const Params& p, int li, int b, int c, int h, char* smem, int wv) {
  const int tid = opaque_tid(wv);
  constexpr int QLD = 136;
  bf16_t* Qs = (bf16_t*)smem;
  bf16_t* Ks = Qs + 64 * QLD;
  float* M0 = (float*)smem;
  float* G = (float*)(smem + 2 * 64 * QLD * 2);
  float* gcs = G + 2 * 64 * 65;
  float* betas = gcs + 128;
  const int lane = tid & 63, w = tid >> 6;
  const int lt0 = c * 64;
  const bool lat = c < NCH_LAT;
  const int s0 = lat ? 0 : SEQ, s1 = lat ? SEQ : NT;
  const size_t gbase = (size_t)b * NT;
  {
    float* cws = G;
    const float* cw = p.gdn_conv_w + (size_t)li * 4 * 1536;
#pragma unroll
    for (int k = 0; k < 6; ++k) {
      const int i = tid + 256 * k;
      const int j = i / 384, c = i - j * 384;
      cws[i] = cw[(size_t)j * 1536 + (c >> 7) * 512 + h * 128 + (c & 127)];
    }
    __syncthreads();
    const int r = tid >> 2, cg = tid & 3;
    const int lt = lt0 + r;
    float tm[4];
    size_t rowoff[4];
#pragma unroll
    for (int j = 0; j < 4; ++j) {
      const int ltj = lt - 1 + j;
      tm[j] = (ltj >= s0 && ltj < s1) ? 1.0f : 0.0f;
      const int ltc = ltj < s0 ? s0 : (ltj >= s1 ? s1 - 1 : ltj);
      rowoff[j] = (gbase + ltc) * 1536;
    }
#pragma unroll 1
    for (int part = 0; part < 3; ++part) {
      const int col0 = part * 512 + h * 128 + cg * 32;
      uint4 xv[4][4];
#pragma unroll
      for (int j = 0; j < 4; ++j)
#pragma unroll
        for (int sub = 0; sub < 4; ++sub) xv[j][sub] = *(const uint4*)(((bf16_t*)(p.ws + WsOff::PQKV)) + rowoff[j] + col0 + sub * 8);
      float vals[32];
#pragma unroll
      for (int sub = 0; sub < 4; ++sub) {
        float y[8];
#pragma unroll
        for (int e = 0; e < 8; ++e) y[e] = 0.f;
#pragma unroll
        for (int j = 0; j < 4; ++j) {
          const float* wj = cws + j * 384 + part * 128 + cg * 32 + sub * 8;
          const float4 w0 = *(const float4*)wj;
          const float4 w1 = *(const float4*)(wj + 4);
          const uint4 x = xv[j][sub];
          const float mj = tm[j];
          y[0] += w0.x * mj * bf2f((bf16_t)(x.x & 0xffff)); y[1] += w0.y * mj * bf2f((bf16_t)(x.x >> 16));
          y[2] += w0.z * mj * bf2f((bf16_t)(x.y & 0xffff)); y[3] += w0.w * mj * bf2f((bf16_t)(x.y >> 16));
          y[4] += w1.x * mj * bf2f((bf16_t)(x.z & 0xffff)); y[5] += w1.y * mj * bf2f((bf16_t)(x.z >> 16));
          y[6] += w1.z * mj * bf2f((bf16_t)(x.w & 0xffff)); y[7] += w1.w * mj * bf2f((bf16_t)(x.w >> 16));
        }
#pragma unroll
        for (int e = 0; e < 8; ++e) vals[sub * 8 + e] = silu_fast(y[e]);
      }
      float sc = 1.0f;
      if (part < 2) {
        float ss = 0.f;
#pragma unroll
        for (int e = 0; e < 32; ++e) ss += vals[e] * vals[e];
        ss += __shfl_xor(ss, 1);
        ss += __shfl_xor(ss, 2);
        sc = rsqrtf(ss + EPS);
        if (part == 0) sc *= 0.08838834764831845f;
      }
      bf16_t* gdst = ((bf16_t*)(p.ws + WsOff::GQ)) + (size_t)part * NALL * 512 + (gbase + lt) * 512 + h * 128 + cg * 32;
      bf16_t* ldst = (part == 0 ? Qs : Ks) + r * QLD + cg * 32;
#pragma unroll
      for (int q = 0; q < 8; ++q) {
        const uint2 pk = pack4(vals[4 * q] * sc, vals[4 * q + 1] * sc, vals[4 * q + 2] * sc, vals[4 * q + 3] * sc);
        *(uint2*)(gdst + 4 * q) = pk;
        if (part < 2) *(uint2*)(ldst + 4 * q) = pk;
      }
    }
  }
  __syncthreads();
  {
    const int mat = w >> 1, i = w & 1;
    const bf16_t* Xs = (mat ? Qs : Ks) + (32 * i + (lane & 31)) * QLD + (lane >> 5) * 8;
    const bf16_t* Ys = Ks + (lane & 31) * QLD + (lane >> 5) * 8;
    f32x16 a0, a1;
#pragma unroll
    for (int r = 0; r < 16; ++r) { a0[r] = 0.f; a1[r] = 0.f; }
#pragma unroll
    for (int ks = 0; ks < 8; ++ks) {
      const bf8_t x = *(const bf8_t*)(Xs + ks * 16);
      const bf8_t y0 = *(const bf8_t*)(Ys + ks * 16);
      const bf8_t y1 = *(const bf8_t*)(Ys + 32 * QLD + ks * 16);
      a0 = __builtin_amdgcn_mfma_f32_32x32x16_bf16(x, y0, a0, 0, 0, 0);
      a1 = __builtin_amdgcn_mfma_f32_32x32x16_bf16(x, y1, a1, 0, 0, 0);
    }
    float* Gm = G + mat * 64 * 65;
#pragma unroll
    for (int r = 0; r < 16; ++r) {
      const int row = 32 * i + acc_row(r, lane);
      Gm[row * 65 + (lane & 31)] = a0[r];
      Gm[row * 65 + 32 + (lane & 31)] = a1[r];
    }
  }
  if (w < 2) {
    const int d = w, pos = lane;
    const int lt = d == 0 ? lt0 + pos : lt0 + 63 - pos;
    const float* ba = ((float*)(p.ws + WsOff::PBA)) + (gbase + lt) * 16;
    const float beta = sigmoid_fast(ba[d * 4 + h]);
    const float x = ba[8 + d * 4 + h] + p.gdn_dt_bias[li * 8 + d * 4 + h];
    const float sp = x > 20.0f ? x : log1pf(__expf(x));
    float g = -__expf(p.gdn_a_log[li * 8 + d * 4 + h]) * sp;
#pragma unroll
    for (int o = 1; o < 64; o <<= 1) {
      const float t = __shfl_up(g, o);
      if (lane >= o) g += t;
    }
    gcs[d * 64 + pos] = g;
    betas[d * 64 + pos] = beta;
    float* gcb = ((float*)(p.ws + WsOff::GCB)) + ((((size_t)b * 2 + d) * 4 + h) * NT + lt0 + pos) * 2;
    gcb[0] = g; gcb[1] = beta;
  }
  __syncthreads();
  {
    const size_t unit = ((size_t)b * NCH + c) * 4 + h;
#pragma unroll
    for (int d = 0; d < 2; ++d) {
      float* Md = M0 + d * 4096;
      bf16_t* at = ((bf16_t*)(p.ws + WsOff::ATTG)) + (unit * 2 + d) * 4096;
#pragma unroll 4
      for (int e = 0; e < 16; ++e) {
        const int idx = tid + 256 * e;
        const int i = idx >> 6, j = idx & 63;
        const int ti = d ? 63 - i : i, tj = d ? 63 - j : j;
        const float dec = i >= j ? __expf(gcs[d * 64 + i] - gcs[d * 64 + j]) : 0.f;
        Md[idx] = i > j ? betas[d * 64 + i] * G[ti * 65 + tj] * dec : 0.f;
        at[idx] = f2bf_dev(G[64 * 65 + ti * 65 + tj] * dec);
      }
    }
  }
  __syncthreads();
  if (w < 2) {
    const int d = w;
#if FWD_PACKED
    typedef float f32x2 __attribute__((ext_vector_type(2)));
    const float* Mi = M0 + d * 4096;
    f32x2 tp[32];
#pragma unroll
    for (int k = 0; k < 32; ++k) tp[k] = (f32x2){0.f, 0.f};
#pragma unroll
    for (int I = 0; I < 64; ++I) {
      f32x2 aA = {0.f, 0.f}, aB = {0.f, 0.f};
#pragma unroll
      for (int j4 = 0; j4 < (I + 3) / 4; ++j4) {
        const float4 m = *(const float4*)(Mi + I * 64 + 4 * j4);
        aA = (f32x2){m.x, m.y} * tp[2 * j4] + aA;
        aB = (f32x2){m.z, m.w} * tp[2 * j4 + 1] + aB;
      }
      const f32x2 s2 = aA + aB;
      tp[I >> 1][I & 1] = ((I == lane) ? 1.0f : 0.0f) - (s2.x + s2.y);
    }
    const size_t unit = ((size_t)b * NCH + c) * 4 + h;
    bf16_t* tg = ((bf16_t*)(p.ws + WsOff::TG)) + (unit * 2 + d) * 4096 + lane;
    const float bc = betas[d * 64 + lane];
#pragma unroll
    for (int i = 0; i < 64; ++i) tg[i * 64] = f2bf_dev(tp[i >> 1][i & 1] * bc);
#else
    float t[64];
    FwdSub<63>::run(M0 + d * 4096, t, lane);
    const size_t unit = ((size_t)b * NCH + c) * 4 + h;
    bf16_t* tg = ((bf16_t*)(p.ws + WsOff::TG)) + (unit * 2 + d) * 4096 + lane;
    const float bc = betas[d * 64 + lane];
#pragma unroll
    for (int i = 0; i < 64; ++i) tg[i * 64] = f2bf_dev(t[i] * bc);
#endif
  }
  __syncthreads();
}

constexpr int LRU_CW_OFF = 77824;
struct LruIn { uint4 a0, a1, a2, a3, b0, b1, b2, b3; };
struct LruW {
  bf8_t r00, r01, r02, r03, i00, i01, i02, i03;
  bf8_t r10, r11, r12, r13, i10, i11, i12, i13;
  float br0, bi0, nls0, br1, bi1, nls1;
};
__device__ __forceinline__ void lru_load_in(const Params& p, int b, int c, int nb, int tid, LruIn& in) {
  const int r = tid >> 2, cg = tid & 3;
  const bool lat = c < NCH_LAT;
  const int s0 = lat ? 0 : SEQ, s1 = lat ? SEQ : NT;
  const int lt = c * 64 + r;
  const bf16_t* base = ((bf16_t*)(p.ws + WsOff::PXR)) + (size_t)b * NT * 512 + nb * 64 + cg * 16;
#define LRU_LD(J_)                                                                                          \
  {                                                                                                         \
    const int ltj = lt - 1 + J_;                                                                            \
    const int ltc = ltj < s0 ? s0 : (ltj >= s1 ? s1 - 1 : ltj);                                             \
    const bf16_t* src = base + (size_t)ltc * 512;                                                           \
    in.a##J_ = *(const uint4*)src; in.b##J_ = *(const uint4*)(src + 8);                                     \
  }
  LRU_LD(0) LRU_LD(1) LRU_LD(2) LRU_LD(3)
#undef LRU_LD
}
__device__ __forceinline__ void lru_load_w(const Params& p, int li, int nb, int tid, LruW& W) {
  const int lane = tid & 63, j = (tid >> 6) & 1;
  const bf16_t* w0 = ((bf16_t*)(p.ws + WsOff::WG)) + ((((size_t)li * 2 + 0) * 2 + 0) * 8 + nb) * 4096 + (32 * j + (lane & 31)) * 64 + (lane >> 5) * 8;
  const bf16_t* w1 = w0 + (size_t)2 * 8 * 4096;
  W.r00 = *(const bf8_t*)(w0); W.r01 = *(const bf8_t*)(w0 + 16); W.r02 = *(const bf8_t*)(w0 + 32); W.r03 = *(const bf8_t*)(w0 + 48);
  W.i00 = *(const bf8_t*)(w0 + 8 * 4096); W.i01 = *(const bf8_t*)(w0 + 8 * 4096 + 16); W.i02 = *(const bf8_t*)(w0 + 8 * 4096 + 32); W.i03 = *(const bf8_t*)(w0 + 8 * 4096 + 48);
  W.r10 = *(const bf8_t*)(w1); W.r11 = *(const bf8_t*)(w1 + 16); W.r12 = *(const bf8_t*)(w1 + 32); W.r13 = *(const bf8_t*)(w1 + 48);
  W.i10 = *(const bf8_t*)(w1 + 8 * 4096); W.i11 = *(const bf8_t*)(w1 + 8 * 4096 + 16); W.i12 = *(const bf8_t*)(w1 + 8 * 4096 + 32); W.i13 = *(const bf8_t*)(w1 + 8 * 4096 + 48);
  const int gch = nb * 64 + 32 * j + (lane & 31);
  W.br0 = p.lru_gate_b[(((size_t)li * 2 + 0) * 2 + 0) * 512 + gch];
  W.bi0 = p.lru_gate_b[(((size_t)li * 2 + 0) * 2 + 1) * 512 + gch];
  W.br1 = p.lru_gate_b[(((size_t)li * 2 + 1) * 2 + 0) * 512 + gch];
  W.bi1 = p.lru_gate_b[(((size_t)li * 2 + 1) * 2 + 1) * 512 + gch];
  const float lam0 = p.lru_lambda[((size_t)li * 2 + 0) * 512 + gch];
  const float lam1 = p.lru_lambda[((size_t)li * 2 + 1) * 512 + gch];
  W.nls0 = lam0 < -20.0f ? -lam0 : log1pf(__expf(-lam0));
  W.nls1 = lam1 < -20.0f ? -lam1 : log1pf(__expf(-lam1));
}
__device__ __forceinline__ void lru_stage_cw(const Params& p, int li, int nb, char* smem, int tid) {
  float* cwl = (float*)(smem + LRU_CW_OFF);
  for (int i = tid; i < 320; i += 256)
    cwl[i] = i < 256 ? p.lru_conv_w[(size_t)li * 4 * 512 + (i >> 6) * 512 + nb * 64 + (i & 63)] : p.lru_conv_b[li * 512 + nb * 64 + (i - 256)];
}

template <bool FINAL, int D>
__device__ __forceinline__ void lru_dir(const Params& p, int b, int c, int nb, const LruW& W, float hin, char* smem, int tid) {
  float* xl = (float*)smem;
  bf16_t* xlb = (bf16_t*)(smem + 16384);
  float* Al = (float*)(smem + 16384 + 9216);
  float* Bl = Al + 4096;
  float* R = Bl + 4096;
  float* SEG = R + 4096;
  const int lane = tid & 63, w = tid >> 6;
  {
    const int i = w >> 1, j = w & 1;
    const bf16_t* Xs = xlb + (32 * i + (lane & 31)) * 72 + (lane >> 5) * 8;
    const bf8_t x0 = *(const bf8_t*)(Xs), x1 = *(const bf8_t*)(Xs + 16), x2 = *(const bf8_t*)(Xs + 32), x3 = *(const bf8_t*)(Xs + 48);
    f32x16 ar, ai;
#pragma unroll
    for (int r = 0; r < 16; ++r) { ar[r] = 0.f; ai[r] = 0.f; }
    ar = __builtin_amdgcn_mfma_f32_32x32x16_bf16(x0, D ? W.r10 : W.r00, ar, 0, 0, 0);
    ai = __builtin_amdgcn_mfma_f32_32x32x16_bf16(x0, D ? W.i10 : W.i00, ai, 0, 0, 0);
    ar = __builtin_amdgcn_mfma_f32_32x32x16_bf16(x1, D ? W.r11 : W.r01, ar, 0, 0, 0);
    ai = __builtin_amdgcn_mfma_f32_32x32x16_bf16(x1, D ? W.i11 : W.i01, ai, 0, 0, 0);
    ar = __builtin_amdgcn_mfma_f32_32x32x16_bf16(x2, D ? W.r12 : W.r02, ar, 0, 0, 0);
    ai = __builtin_amdgcn_mfma_f32_32x32x16_bf16(x2, D ? W.i12 : W.i02, ai, 0, 0, 0);
    ar = __builtin_amdgcn_mfma_f32_32x32x16_bf16(x3, D ? W.r13 : W.r03, ar, 0, 0, 0);
    ai = __builtin_amdgcn_mfma_f32_32x32x16_bf16(x3, D ? W.i13 : W.i03, ai, 0, 0, 0);
    const int ch = 32 * j + (lane & 31);
    const float br = D ? W.br1 : W.br0, bi = D ? W.bi1 : W.bi0, nls = D ? W.nls1 : W.nls0;
#pragma unroll
    for (int r = 0; r < 16; ++r) {
      const int tok = 32 * i + acc_row(r, lane);
      const float rg = sigmoid_fast(ar[r] + br), ig = sigmoid_fast(ai[r] + bi);
      const float a = __expf(-8.0f * rg * nls);
      Al[tok * 64 + ch] = a;
      Bl[tok * 64 + ch] = sqrtf(fmaxf(1.0f - a * a, 0.f)) * ig * xl[tok * 64 + ch];
    }
  }
  __syncthreads();
  {
    const int ch = tid & 63, seg = tid >> 6;
    float ap = 1.0f, hb = 0.f;
#pragma unroll
    for (int s = 0; s < 16; ++s) {
      const int st = 16 * seg + s;
      const int tok = D == 0 ? st : 63 - st;
      const float a = Al[tok * 64 + ch];
      hb = a * hb + Bl[tok * 64 + ch];
      ap *= a;
    }
    SEG[(seg * 64 + ch) * 2] = ap;
    SEG[(seg * 64 + ch) * 2 + 1] = hb;
    __syncthreads();
    if (!FINAL) {
      if (seg == 0) {
        const size_t cidx = (((size_t)b * 2 + D) * NCH + c) * 512 + nb * 64 + ch;
        float A = 1.0f, Bv = 0.f;
#pragma unroll
        for (int s2 = 0; s2 < 4; ++s2) {
          const float2 sg2 = *(const float2*)(SEG + (s2 * 64 + ch) * 2);
          Bv = sg2.x * Bv + sg2.y;
          A *= sg2.x;
        }
        *(float2*)(((float*)(p.ws + WsOff::LCAR)) + cidx * 2) = make_float2(A, Bv);
      }
    } else {
      float hcur = hin;
      for (int s2 = 0; s2 < seg; ++s2) hcur = SEG[(s2 * 64 + ch) * 2] * hcur + SEG[(s2 * 64 + ch) * 2 + 1];
#pragma unroll
      for (int s = 0; s < 16; ++s) {
        const int st = 16 * seg + s;
        const int tok = D == 0 ? st : 63 - st;
        hcur = Al[tok * 64 + ch] * hcur + Bl[tok * 64 + ch];
        if (D == 0) R[tok * 64 + ch] = hcur;
        else R[tok * 64 + ch] += hcur;
      }
    }
  }
  __syncthreads();
}

template <bool FINAL>
__device__ __forceinline__ void lru_chunk_unit(const Params& p, int b, int c, int nb, LruIn& in, bool has_next, int b2, int c2,
                                               const LruW& W, char* smem, int tid) {
  float* xl = (float*)smem;
  bf16_t* xlb = (bf16_t*)(smem + 16384);
  float* R = (float*)(smem + 16384 + 9216) + 2 * 4096;
  const float* cwl = (const float*)(smem + LRU_CW_OFF);
  const int lt0 = c * 64;
  const bool lat = c < NCH_LAT;
  const int s0 = lat ? 0 : SEQ, s1 = lat ? SEQ : NT;
  const size_t gbase = (size_t)b * NT;
  float hin0 = 0.f, hin1 = 0.f;
  if (FINAL) {
    const size_t cidx = (((size_t)b * 2) * NCH + c) * 512 + nb * 64 + (tid & 63);
    hin0 = ((float*)(p.ws + WsOff::LHIN))[cidx];
    hin1 = ((float*)(p.ws + WsOff::LHIN))[cidx + (size_t)NCH * 512];
  }
  {
    const int r = tid >> 2, cg = tid & 3;
    const int lt = lt0 + r;
    float y[16];
#pragma unroll
    for (int q = 0; q < 4; ++q) {
      const float4 bv = *(const float4*)(cwl + 256 + cg * 16 + 4 * q);
      y[4 * q] = bv.x; y[4 * q + 1] = bv.y; y[4 * q + 2] = bv.z; y[4 * q + 3] = bv.w;
    }
#define LRU_TAP(J_)                                                                                         \
  {                                                                                                         \
    const int ltj = lt - 1 + J_;                                                                            \
    const float mk = (ltj >= s0 && ltj < s1) ? 1.0f : 0.0f;                                                 \
    const uint4 x0 = in.a##J_, x1 = in.b##J_;                                                               \
    const float* wrow = cwl + J_ * 64 + cg * 16;                                                            \
    const float4 w0 = *(const float4*)(wrow), w1 = *(const float4*)(wrow + 4), w2 = *(const float4*)(wrow + 8),  \
                 w3 = *(const float4*)(wrow + 12);                                                          \
    y[0] += w0.x * mk * bf2f((bf16_t)(x0.x & 0xffff)); y[1] += w0.y * mk * bf2f((bf16_t)(x0.x >> 16));      \
    y[2] += w0.z * mk * bf2f((bf16_t)(x0.y & 0xffff)); y[3] += w0.w * mk * bf2f((bf16_t)(x0.y >> 16));      \
    y[4] += w1.x * mk * bf2f((bf16_t)(x0.z & 0xffff)); y[5] += w1.y * mk * bf2f((bf16_t)(x0.z >> 16));      \
    y[6] += w1.z * mk * bf2f((bf16_t)(x0.w & 0xffff)); y[7] += w1.w * mk * bf2f((bf16_t)(x0.w >> 16));      \
    y[8] += w2.x * mk * bf2f((bf16_t)(x1.x & 0xffff)); y[9] += w2.y * mk * bf2f((bf16_t)(x1.x >> 16));      \
    y[10] += w2.z * mk * bf2f((bf16_t)(x1.y & 0xffff)); y[11] += w2.w * mk * bf2f((bf16_t)(x1.y >> 16));    \
    y[12] += w3.x * mk * bf2f((bf16_t)(x1.z & 0xffff)); y[13] += w3.y * mk * bf2f((bf16_t)(x1.z >> 16));    \
    y[14] += w3.z * mk * bf2f((bf16_t)(x1.w & 0xffff)); y[15] += w3.w * mk * bf2f((bf16_t)(x1.w >> 16));    \
  }
    LRU_TAP(0) LRU_TAP(1) LRU_TAP(2) LRU_TAP(3)
#undef LRU_TAP
#pragma unroll
    for (int q = 0; q < 4; ++q) {
      *(float4*)(xl + r * 64 + cg * 16 + 4 * q) = make_float4(y[4 * q], y[4 * q + 1], y[4 * q + 2], y[4 * q + 3]);
      *(uint2*)(xlb + r * 72 + cg * 16 + 4 * q) = pack4(y[4 * q], y[4 * q + 1], y[4 * q + 2], y[4 * q + 3]);
    }
  }
  if (has_next) lru_load_in(p, b2, c2, nb, tid, in);
  asm volatile("" ::: "memory");
  __syncthreads();
  lru_dir<FINAL, 0>(p, b, c, nb, W, hin0, smem, tid);
  lru_dir<FINAL, 1>(p, b, c, nb, W, hin1, smem, tid);
  if (FINAL) {
    const int r = tid >> 2, cg = tid & 3;
    const size_t gt = gbase + lt0 + r;
    const bf16_t* gr = ((bf16_t*)(p.ws + WsOff::PZG)) + gt * 1024 + 512 + nb * 64 + cg * 16;
    bf16_t* dst = ((bf16_t*)(p.ws + WsOff::mixh)) + gt * 1024 + 512 + nb * 64 + cg * 16;
#pragma unroll
    for (int q = 0; q < 4; ++q) {
      const uint2 gv = *(const uint2*)(gr + 4 * q);
      const float4 rv = *(const float4*)(R + r * 64 + cg * 16 + 4 * q);
      *(uint2*)(dst + 4 * q) = pack4(rv.x * silu_fast(bf2f((bf16_t)(gv.x & 0xffff))), rv.y * silu_fast(bf2f((bf16_t)(gv.x >> 16))),
                                     rv.z * silu_fast(bf2f((bf16_t)(gv.y & 0xffff))), rv.w * silu_fast(bf2f((bf16_t)(gv.y >> 16))));
    }
    __syncthreads();
  }
}

constexpr int N_EDGE = 14;
constexpr int N_EARLY = (NCH - NCH_LAT) + 2 * N_EDGE;
constexpr int N_LATE = NCH - N_EARLY;
constexpr int SCAN_WAIT_STEP = (NCH - NCH_LAT) + N_EDGE;
__device__ __forceinline__ int early_chunk(int i) {
  if (i < NCH - NCH_LAT) return NCH_LAT + i;
  const int k = i - (NCH - NCH_LAT);
  return k < N_EDGE ? k : NCH_LAT - 2 * N_EDGE + k;
}
template <int SEL>
__device__ void rec_chunk_phase(const Params& p_, int li, char* smem, int wv) {
  const Params p = phase_params(p_);
  constexpr int U_E = NB * N_EARLY * 4;
  for (int u = blockIdx.x; u < U_E; u += gridDim.x) {
    const int h = u & 3, c = early_chunk((u >> 2) % N_EARLY), b = (u >> 2) / N_EARLY;
    gdn_chunk_unit(p, li, b, c, h, smem, wv);
  }
  convert_outproj(p, 2 * li + 1, smem, opaque_tid(wv));
}

__device__ __forceinline__ int scan_chunk(int d, int n) {
  constexpr int NCTX = NCH - NCH_LAT;
  if (n < NCTX) return d == 0 ? NCH_LAT + n : NCH - 1 - n;
  const int m = n - NCTX;
  return d == 0 ? m : NCH_LAT - 1 - m;
}

__device__ __forceinline__ bf8_t ld_split(const bf16_t* p) {
  const uint2 lo = *(const uint2*)p;
  const uint2 hi = *(const uint2*)(p + 8);
  uint4 v = make_uint4(lo.x, lo.y, hi.x, hi.y);
  return *(bf8_t*)&v;
}
__device__ __forceinline__ bf8_t acc_frag(const f32x16& a, int half) {
  bf8_t f;
#pragma unroll
  for (int e = 0; e < 8; ++e) f[e] = (__bf16)a[8 * half + e];
  return f;
}

typedef __attribute__((ext_vector_type(4))) short s4_t;
__device__ __forceinline__ bf8_t ld_tr_split(const bf16_t* p0, int ld) {
  typedef __attribute__((address_space(3))) s4_t* lds_s4p;
  const s4_t lo = __builtin_amdgcn_ds_read_tr16_b64_v4i16((lds_s4p)(p0));
  const s4_t hi = __builtin_amdgcn_ds_read_tr16_b64_v4i16((lds_s4p)(p0 + 8 * ld));
  bf8_t f;
  *(s4_t*)&f = lo;
  *((s4_t*)&f + 1) = hi;
  return f;
}

typedef __attribute__((ext_vector_type(4))) float f32x4;
__device__ __forceinline__ bf8_t ld_split16(const bf16_t* p) {
  const uint2 lo = *(const uint2*)p;
  const uint2 hi = *(const uint2*)(p + 16);
  uint4 v = make_uint4(lo.x, lo.y, hi.x, hi.y);
  return *(bf8_t*)&v;
}
__device__ __forceinline__ bf8_t ld_tr_split16(const bf16_t* p0, int ld) {
  typedef __attribute__((address_space(3))) s4_t* lds_s4p;
  const s4_t lo = __builtin_amdgcn_ds_read_tr16_b64_v4i16((lds_s4p)(p0));
  const s4_t hi = __builtin_amdgcn_ds_read_tr16_b64_v4i16((lds_s4p)(p0 + 16 * ld));
  bf8_t f;
  *(s4_t*)&f = lo;
  *((s4_t*)&f + 1) = hi;
  return f;
}
__device__ __forceinline__ bf8_t acc_frag16(const f32x4& t0, const f32x4& t1) {
  bf8_t f;
#pragma unroll
  for (int e = 0; e < 4; ++e) { f[e] = (__bf16)t0[e]; f[4 + e] = (__bf16)t1[e]; }
  return f;
}

__device__ void gdn_scan_block(const Params& p, int b, int d, int h, int hv, unsigned* late_cnt, int hot, char* smem, int tid) {
  constexpr int QLD = 136, TLD = 72;
  constexpr int KLD = 128;
  bf16_t* Ks = (bf16_t*)smem;
  bf16_t* Qs = Ks + 64 * KLD;
  bf16_t* Vs = Qs + 64 * QLD;
  bf16_t* Ts = Vs + 64 * TLD;
  bf16_t* As = Ts + 64 * TLD;
  float* egs = (float*)(As + 64 * TLD);
  float* dls = egs + 128;
  const int lane = tid & 63, w = tid >> 6;
  const int m15 = lane & 15, g4 = (lane >> 4) * 4;
  const char* const pGK = (const char*)(((bf16_t*)(p.ws + WsOff::GK)) + (size_t)b * NT * 512 + h * 128);
  const char* const pGQ = (const char*)(((bf16_t*)(p.ws + WsOff::GQ)) + (size_t)b * NT * 512 + h * 128);
  const char* const pGV = (const char*)(((bf16_t*)(p.ws + WsOff::GV)) + (size_t)b * NT * 512 + h * 128 + hv * 64);
  const char* const pTG = (const char*)(((bf16_t*)(p.ws + WsOff::TG)) + ((size_t)b * NCH * 4 + h) * 2 * 4096 + d * 4096);
  const char* const pAT = (const char*)(((bf16_t*)(p.ws + WsOff::ATTG)) + ((size_t)b * NCH * 4 + h) * 2 * 4096 + d * 4096);
  const char* const pGCB = (const char*)(((float*)(p.ws + WsOff::GCB)) + (((size_t)b * 2 + d) * 4 + h) * NT * 2);
  bf16_t* const pOD = hot ? ((bf16_t*)(p.ws + WsOff::PQKV)) + ((size_t)b * 2 + d) * NT * 512 + h * 128 + hv * 64
                          : (d == 0 ? ((bf16_t*)(p.ws + WsOff::mixh)) + (size_t)b * NT * 1024 + h * 128 + hv * 64 : ((bf16_t*)(p.ws + WsOff::OD1)) + (size_t)b * NT * 512 + h * 128 + hv * 64);
  const unsigned ods = (d == 0 && !hot) ? 1024u : 512u;
  const unsigned odl = (unsigned)(16 * w + m15);
  const unsigned krow = (unsigned)(tid >> 4), kpart = (unsigned)(tid & 15);
  const unsigned vrow = (unsigned)(tid >> 3), vpart = (unsigned)(tid & 7);
  const unsigned kperm = (kpart >> 2) * 32 + (kpart & 1) * 16 + ((kpart >> 1) & 1) * 4;
  const unsigned kswz = ((krow & 3) << 1) | ((krow >> 2) & 1);
  const unsigned kp0 = (4 * (kpart >> 2) + 2 * (kpart & 1)) ^ kswz;
  const unsigned koff0 = 8 * kp0 + 4 * ((kpart >> 1) & 1), koff1 = 8 * (kp0 ^ 1) + 4 * ((kpart >> 1) & 1);
  const unsigned vperm = (vpart >> 2) * 32 + (vpart & 1) * 16 + ((vpart >> 1) & 1) * 4;
  uint4 sk0, sk1, sk2, sk3, sq0, sq1, sq2, sq3, sv0, sv1, st0, st1, sa0, sa1, sg;
  sg = make_uint4(0, 0, 0, 0);
  float sgl = 0.f;
  f32x4 S[8];
#pragma unroll
  for (int t = 0; t < 8; ++t)
#pragma unroll
    for (int r = 0; r < 4; ++r) S[t][r] = 0.f;
#define SCAN_LD_KQ(K_)                                                                                      \
  {                                                                                                         \
    const unsigned row = krow + 16 * K_;                                                                    \
    const unsigned off = ((unsigned)(c_ * 64) + (d ? 63u - row : row)) * 1024u + kpart * 16u;               \
    sk##K_ = *(const uint4*)(pGK + off);                                                                    \
    sq##K_ = *(const uint4*)(pGQ + off);                                                                    \
  }
#define SCAN_LD_VTA(K_)                                                                                     \
  {                                                                                                         \
    const unsigned row = vrow + 32 * K_;                                                                    \
    sv##K_ = *(const uint4*)(pGV + ((unsigned)(c_ * 64) + (d ? 63u - row : row)) * 1024u + vpart * 16u);   \
    const unsigned off = (unsigned)c_ * (4u * 2u * 8192u) + row * 128u + vpart * 16u;                       \
    st##K_ = *(const uint4*)(pTG + off);                                                                    \
    sa##K_ = *(const uint4*)(pAT + off);                                                                    \
  }
#define SCAN_LD_G()                                                                                         \
  {                                                                                                         \
    if (tid < 32) {                                                                                         \
      sg = *(const uint4*)(pGCB + (unsigned)(c_ * 64) * 8u + (unsigned)tid * 16u);                          \
      sgl = *(const float*)(pGCB + (unsigned)(c_ * 64 + 63) * 8u);                                          \
    }                                                                                                       \
  }
#define SCAN_ST_KQ(K_)                                                                                      \
  {                                                                                                         \
    const unsigned o_ = (krow + 16 * K_) * QLD + kperm;                                                     \
    const unsigned ok_ = (krow + 16 * K_) * KLD;                                                            \
    *(uint2*)(Ks + ok_ + koff0) = make_uint2(sk##K_.x, sk##K_.y); *(uint2*)(Ks + ok_ + koff1) = make_uint2(sk##K_.z, sk##K_.w); \
    *(uint2*)(Qs + o_) = make_uint2(sq##K_.x, sq##K_.y); *(uint2*)(Qs + o_ + 8) = make_uint2(sq##K_.z, sq##K_.w); \
  }
#define SCAN_ST_VTA(K_)                                                                                     \
  {                                                                                                         \
    const unsigned o_ = (vrow + 32 * K_) * TLD + vpart * 8;                                                 \
    const unsigned op_ = (vrow + 32 * K_) * TLD + vperm;                                                    \
    *(uint4*)(Vs + o_) = sv##K_;                                                                            \
    *(uint2*)(Ts + op_) = make_uint2(st##K_.x, st##K_.y); *(uint2*)(Ts + op_ + 8) = make_uint2(st##K_.z, st##K_.w); \
    *(uint2*)(As + op_) = make_uint2(sa##K_.x, sa##K_.y); *(uint2*)(As + op_ + 8) = make_uint2(sa##K_.z, sa##K_.w); \
  }
#define SCAN_STORE()                                                                                        \
  {                                                                                                         \
    SCAN_ST_KQ(0) SCAN_ST_KQ(1) SCAN_ST_KQ(2) SCAN_ST_KQ(3) SCAN_ST_VTA(0) SCAN_ST_VTA(1)                   \
    if (tid < 32) {                                                                                         \
      const float g0_ = __uint_as_float(sg.x), g1_ = __uint_as_float(sg.z);                                 \
      *(float2*)(egs + tid * 2) = make_float2(__expf(g0_), __expf(g1_));                                    \
      *(float2*)(dls + tid * 2) = make_float2(__expf(sgl - g0_), __expf(sgl - g1_));                        \
      if (tid == 0) dls[64] = __expf(sgl);                                                                  \
    }                                                                                                       \
  }
  {
    const int c_ = hot ? 0 : scan_chunk(d, 0);
    SCAN_LD_KQ(0) SCAN_LD_KQ(1) SCAN_LD_KQ(2) SCAN_LD_KQ(3) SCAN_LD_VTA(0) SCAN_LD_VTA(1) SCAN_LD_G()
  }
  SCAN_STORE();
  __syncthreads();
  const int kflip = (m15 >> 1) & 1, klow = (lane >> 4) ^ (((m15 & 1) << 1) | ((m15 >> 2) & 1));
  const bf16_t* const KfrA = Ks + m15 * KLD + 8 * klow + 32 * kflip;
  const bf16_t* const KfrB = Ks + m15 * KLD + 8 * klow + 32 * (1 - kflip);
  const bf16_t* const Qfr = Qs + m15 * QLD + 2 * g4;
  const bf16_t* const Tfr = Ts + m15 * TLD + 2 * g4;
  const bf16_t* const Afr = As + m15 * TLD + 2 * g4;
  const int tq = m15 >> 2, tflip = (tq >> 1) & 1, tlow = (lane & 3) ^ (((tq & 1) << 1) | ((lane >> 4) & 1));
  const bf16_t* const KTA = Ks + (g4 + tq) * KLD + 8 * tlow + 32 * tflip;
  const bf16_t* const KTB = Ks + (g4 + tq) * KLD + 8 * tlow + 32 * (1 - tflip);
  const bf16_t* const Vfr = Vs + (g4 + (m15 >> 2)) * TLD + 16 * w + 4 * (lane & 3);
  typedef __attribute__((address_space(3))) s4_t* lds_s4p_t;
#define SB() __builtin_amdgcn_sched_barrier(0)
#define LDF4(F_, BASE_, LD_, KK_)                                                                           \
  {                                                                                                         \
    F_##0 = *(const bf8_t*)(BASE_ + 32 * (KK_));                                                            \
    F_##1 = *(const bf8_t*)(BASE_ + 16 * LD_ + 32 * (KK_));                                                 \
    F_##2 = *(const bf8_t*)(BASE_ + 32 * LD_ + 32 * (KK_));                                                 \
    F_##3 = *(const bf8_t*)(BASE_ + 48 * LD_ + 32 * (KK_));                                                 \
  }
#define MF4(A_, F_, B_)                                                                                     \
  {                                                                                                         \
    A_##0 = __builtin_amdgcn_mfma_f32_16x16x32_bf16(F_##0, B_, A_##0, 0, 0, 0);                             \
    A_##1 = __builtin_amdgcn_mfma_f32_16x16x32_bf16(F_##1, B_, A_##1, 0, 0, 0);                             \
    A_##2 = __builtin_amdgcn_mfma_f32_16x16x32_bf16(F_##2, B_, A_##2, 0, 0, 0);                             \
    A_##3 = __builtin_amdgcn_mfma_f32_16x16x32_bf16(F_##3, B_, A_##3, 0, 0, 0);                             \
    asm volatile("" : "+v"(A_##0), "+v"(A_##1), "+v"(A_##2), "+v"(A_##3));                                  \
  }
#define MF4S(A_, F_, K_)                                                                                    \
  {                                                                                                         \
    asm volatile("" : "+v"(S[2 * K_]), "+v"(S[2 * K_ + 1]));                                                \
    const bf8_t sb_ = acc_frag16(S[2 * K_], S[2 * K_ + 1]);                                                 \
    MF4(A_, F_, sb_)                                                                                        \
  }
#define LDKT(F_, T0_)                                                                                       \
  {                                                                                                         \
    const bf16_t* const kt_ = ((((T0_) >> 1) & 1) ? KTB : KTA) + 64 * ((T0_) >> 2);                         \
    F_##0 = ld_tr_split16(kt_, KLD);                                                                        \
    F_##1 = ld_tr_split16(kt_ + 32 * KLD, KLD);                                                             \
    F_##2 = ld_tr_split16(kt_ + 4, KLD);                                                                    \
    F_##3 = ld_tr_split16(kt_ + 32 * KLD + 4, KLD);                                                         \
  }
#define MFKT(F_, T0_)                                                                                       \
  {                                                                                                         \
    S[T0_] = __builtin_amdgcn_mfma_f32_16x16x32_bf16(F_##0, vk0, S[T0_], 0, 0, 0);                          \
    S[(T0_) + 1] = __builtin_amdgcn_mfma_f32_16x16x32_bf16(F_##2, vk0, S[(T0_) + 1], 0, 0, 0);              \
    S[T0_] = __builtin_amdgcn_mfma_f32_16x16x32_bf16(F_##1, vk1, S[T0_], 0, 0, 0);                          \
    S[(T0_) + 1] = __builtin_amdgcn_mfma_f32_16x16x32_bf16(F_##3, vk1, S[(T0_) + 1], 0, 0, 0);              \
    asm volatile("" : "+v"(S[T0_]), "+v"(S[(T0_) + 1]));                                                    \
  }
  for (int n = 0; n < NCH; ++n) {
    if (n + 1 == SCAN_WAIT_STEP && late_cnt) wait_ge(late_cnt, (unsigned)(NB * N_LATE * 4), tid);
    bf8_t fa0, fa1, fa2, fa3, fb0, fb1, fb2, fb3;
    LDF4(fa, KfrA, KLD, 0) LDF4(fb, KfrB, KLD, 0)
    SB();
    const int c_ = hot ? 0 : scan_chunk(d, n + 1 < NCH ? n + 1 : n);
    const int c = scan_chunk(d, n);
    f32x4 a0 = {0.f, 0.f, 0.f, 0.f}, a1 = a0, a2 = a0, a3 = a0;
    MF4S(a, fa, 0)
    SB();
    LDF4(fa, KfrA, KLD, 2)
    SCAN_LD_KQ(0)
    SB();
    MF4S(a, fb, 1)
    SB();
    LDF4(fb, KfrB, KLD, 2)
    SCAN_LD_KQ(1)
    SB();
    MF4S(a, fa, 2)
    SB();
    LDF4(fa, Tfr, TLD, 0)
    SCAN_LD_KQ(2)
    SB();
    MF4S(a, fb, 3)
    SB();
    SCAN_LD_KQ(3)
    {
      const f32x4 eg0 = *(const f32x4*)(egs + g4), eg1 = *(const f32x4*)(egs + 16 + g4), eg2 = *(const f32x4*)(egs + 32 + g4),
                  eg3 = *(const f32x4*)(egs + 48 + g4);
      const s4_t vv0 = __builtin_amdgcn_ds_read_tr16_b64_v4i16((lds_s4p_t)(Vfr)), vv1 = __builtin_amdgcn_ds_read_tr16_b64_v4i16((lds_s4p_t)(Vfr + 16 * TLD)),
                 vv2 = __builtin_amdgcn_ds_read_tr16_b64_v4i16((lds_s4p_t)(Vfr + 32 * TLD)), vv3 = __builtin_amdgcn_ds_read_tr16_b64_v4i16((lds_s4p_t)(Vfr + 48 * TLD));
      fb0 = *(const bf8_t*)(Tfr + 32 * TLD + 32); fb1 = *(const bf8_t*)(Tfr + 48 * TLD + 32);
      SB();
#define RT_EPI(I_)                                                                                          \
  _Pragma("unroll") for (int r = 0; r < 4; ++r)                                                             \
      a##I_[r] = bf2f((unsigned short)vv##I_[r]) - eg##I_[r] * a##I_[r];
      RT_EPI(0) RT_EPI(1) RT_EPI(2) RT_EPI(3)
#undef RT_EPI
    }
    const bf8_t rb0 = acc_frag16(a0, a1), rb1 = acc_frag16(a2, a3);
    f32x4 vn0 = {0.f, 0.f, 0.f, 0.f}, vn1 = vn0, vn2 = vn0, vn3 = vn0;
    MF4(vn, fa, rb0)
    SB();
    LDF4(fa, Qfr, QLD, 0)
    SCAN_LD_VTA(0)
    SB();
    vn2 = __builtin_amdgcn_mfma_f32_16x16x32_bf16(fb0, rb1, vn2, 0, 0, 0);
    vn3 = __builtin_amdgcn_mfma_f32_16x16x32_bf16(fb1, rb1, vn3, 0, 0, 0);
    asm volatile("" : "+v"(vn2), "+v"(vn3));
    SB();
    LDF4(fb, Qfr, QLD, 1)
    SCAN_LD_VTA(1)
    SB();
    f32x4 o0 = {0.f, 0.f, 0.f, 0.f}, o1 = o0, o2 = o0, o3 = o0;
    MF4S(o, fa, 0)
    SB();
    LDF4(fa, Qfr, QLD, 2)
    SCAN_LD_G()
    SB();
    MF4S(o, fb, 1)
    SB();
    LDF4(fb, Qfr, QLD, 3)
    SB();
    MF4S(o, fa, 2)
    SB();
    LDF4(fa, Afr, TLD, 0)
    const f32x4 eg0 = *(const f32x4*)(egs + g4), eg1 = *(const f32x4*)(egs + 16 + g4), eg2 = *(const f32x4*)(egs + 32 + g4),
                eg3 = *(const f32x4*)(egs + 48 + g4);
    SB();
    MF4S(o, fb, 3)
    SB();
    fb0 = *(const bf8_t*)(Afr + 32 * TLD + 32); fb1 = *(const bf8_t*)(Afr + 48 * TLD + 32);
    SB();
    {
      const bf8_t vb0 = acc_frag16(vn0, vn1), vb1 = acc_frag16(vn2, vn3);
#define O_SC(I_) _Pragma("unroll") for (int r = 0; r < 4; ++r) o##I_[r] *= eg##I_[r];
      O_SC(0) O_SC(1) O_SC(2) O_SC(3)
#undef O_SC
      MF4(o, fa, vb0)
      SB();
      LDKT(fa, 0)
      SB();
      o2 = __builtin_amdgcn_mfma_f32_16x16x32_bf16(fb0, vb1, o2, 0, 0, 0);
      o3 = __builtin_amdgcn_mfma_f32_16x16x32_bf16(fb1, vb1, o3, 0, 0, 0);
      asm volatile("" : "+v"(o2), "+v"(o3));
    }
    SB();
    LDKT(fb, 2)
    const f32x4 dl0 = *(const f32x4*)(dls + g4), dl1 = *(const f32x4*)(dls + 16 + g4), dl2 = *(const f32x4*)(dls + 32 + g4),
                dl3 = *(const f32x4*)(dls + 48 + g4);
    const float egl_all = dls[64];
    SB();
#define VN_SC(I_) _Pragma("unroll") for (int r = 0; r < 4; ++r) vn##I_[r] *= dl##I_[r];
    VN_SC(0) VN_SC(1) VN_SC(2) VN_SC(3)
#undef VN_SC
    const bf8_t vk0 = acc_frag16(vn0, vn1), vk1 = acc_frag16(vn2, vn3);
#pragma unroll
    for (int t = 0; t < 8; ++t)
#pragma unroll
      for (int r = 0; r < 4; ++r) S[t][r] *= egl_all;
    MFKT(fa, 0)
    SB();
    LDKT(fa, 4)
    SB();
#define O_ST(I_)                                                                                            \
  _Pragma("unroll") for (int r = 0; r < 4; ++r) {                                                           \
    const int pos = 16 * I_ + g4 + r;                                                                       \
    const int lt = c * 64 + (d ? 63 - pos : pos);                                                           \
    pOD[(unsigned)lt * ods + odl] = f2bf_dev(o##I_[r]);                                                     \
  }
    O_ST(0) O_ST(1) O_ST(2) O_ST(3)
#undef O_ST
    MFKT(fb, 2)
    SB();
    LDKT(fb, 6)
    SB();
    MFKT(fa, 4)
    SB();
    MFKT(fb, 6)
    SB();
    {
#if SCAN_RAW_BAR
      asm volatile("s_waitcnt lgkmcnt(0)\n\ts_barrier" ::: "memory");
      if (n + 1 < NCH) SCAN_STORE();
      asm volatile("s_waitcnt lgkmcnt(0)\n\ts_barrier" ::: "memory");
#else
      __syncthreads();
      if (n + 1 < NCH) SCAN_STORE();
      __syncthreads();
#endif
    }
  }
#undef SB
#undef LDF4
#undef MF4
#undef LDKT
#undef MF4S
#undef MFKT
#undef SCAN_LD_G
#undef SCAN_STORE
#undef SCAN_LD_KQ
#undef SCAN_LD_VTA
#undef SCAN_ST_KQ
#undef SCAN_ST_VTA
}

__device__ void rec_scan_phase(const Params& p_, int li, int cslot, int MODE, char* smem, int wv) {
  const Params p = phase_params(p_);
  const int tid = opaque_tid(wv);
  constexpr int NGDN = NB * 2 * 4 * 2;
  constexpr int NLRU = NB * 2 * 512 / 256;
  constexpr int U_L = NB * NCH * 8;
  const int bid = blockIdx.x;
  if (bid < NGDN) {
    const int hv = bid & 1, h = (bid >> 1) & 3, d = (bid >> 3) & 1, b = bid >> 4;
    if (MODE < 2 || MODE == 3) gdn_scan_block(p, b, d, h, hv, MODE != 0 ? nullptr : ((unsigned*)(p.ws + WsOff::bar)) + 4 * cslot + 2, MODE == 3, smem, tid);
    return;
  }
  if (MODE == 1 || MODE == 3) return;
  const int nw = (int)gridDim.x - NGDN, me = bid - NGDN;
  unsigned* cnt1 = ((unsigned*)(p.ws + WsOff::bar)) + 4 * cslot;
  unsigned* cnt2 = ((unsigned*)(p.ws + WsOff::bar)) + 4 * cslot + 1;
  if (MODE != 5 && MODE != 6) {
    constexpr int U_LATE = NB * N_LATE * 4;
    unsigned done = 0;
    for (int u = me; u < U_LATE; u += nw) {
      const int h = u & 3, c = N_EDGE + (u >> 2) % N_LATE, b = (u >> 2) / N_LATE;
      gdn_chunk_unit(p, li, b, c, h, smem, wv);
      ++done;
    }
    signal_add(((unsigned*)(p.ws + WsOff::bar)) + 4 * cslot + 2, done, tid);
  }
  if (MODE == 4) return;
  constexpr int NBC = NB * NCH;
  const int nwg = nw >> 3, nb = me & 7, grp = me >> 3;
  LruW W;
  LruIn in;
  if (grp < nwg) {
    lru_load_w(p, li, nb, tid, W);
    lru_stage_cw(p, li, nb, smem, tid);
    if (grp < NBC) lru_load_in(p, grp / NCH, grp % NCH, nb, tid, in);
    __syncthreads();
    unsigned done = 0;
    for (int k = grp; k < NBC; k += nwg) {
      const int k2 = k + nwg;
      lru_chunk_unit<false>(p, k / NCH, k % NCH, nb, in, k2 < NBC, k2 / NCH, k2 % NCH, W, smem, tid);
      ++done;
    }
    signal_add(cnt1, done, tid);
  }
  if (MODE == 5) return;
  if (me < NLRU) {
    wait_ge(cnt1, (unsigned)U_L, tid);
    const int chain = me * 256 + tid;
    const int ch = chain & 511, d = (chain >> 9) & 1, b = chain >> 10;
    float hcur = 0.f;
    const float2* car = (const float2*)((float*)(p.ws + WsOff::LCAR)) + ((size_t)b * 2 + d) * NCH * 512 + ch;
    float* hin = ((float*)(p.ws + WsOff::LHIN)) + ((size_t)b * 2 + d) * NCH * 512 + ch;
#pragma unroll 1
    for (int n0 = 0; n0 < NCH; n0 += 17) {
      float2 ab[17];
#pragma unroll
      for (int k = 0; k < 17; ++k) ab[k] = car[(size_t)scan_chunk(d, n0 + k) * 512];
#pragma unroll
      for (int k = 0; k < 17; ++k) {
        hin[(size_t)scan_chunk(d, n0 + k) * 512] = hcur;
        hcur = ab[k].x * hcur + ab[k].y;
      }
    }
    signal_add(cnt2, 1u, tid);
  }
  if (grp < nwg) {
    if (grp < NBC) lru_load_in(p, grp / NCH, grp % NCH, nb, tid, in);
    wait_ge(cnt2, (unsigned)NLRU, tid);
    for (int k = grp; k < NBC; k += nwg) {
      const int k2 = k + nwg;
      lru_chunk_unit<true>(p, k / NCH, k % NCH, nb, in, k2 < NBC, k2 / NCH, k2 % NCH, W, smem, tid);
    }
  }
}

__device__ void rec_mix_phase(const Params& p_, int li, char* smem, int wv) {
  const Params p = phase_params(p_);
  const int tid = opaque_tid(wv);
  {
    const long ngrp = (long)NALL * 4;
    const int sub = tid & 15;
    for (long g = ((long)blockIdx.x * 256 + tid) >> 4; g < ngrp; g += ((long)gridDim.x * 256) >> 4) {
      const size_t gt = (size_t)(g >> 2);
      const int h = (int)(g & 3);
      const uint4 o0 = *(const uint4*)(((bf16_t*)(p.ws + WsOff::mixh)) + gt * 1024 + h * 128 + sub * 8);
      const uint4 o1 = *(const uint4*)(((bf16_t*)(p.ws + WsOff::OD1)) + gt * 512 + h * 128 + sub * 8);
      const uint4 zv = *(const uint4*)(((bf16_t*)(p.ws + WsOff::PZG)) + gt * 1024 + h * 128 + sub * 8);
      float o[8];
      const unsigned* a0 = (const unsigned*)&o0; const unsigned* a1 = (const unsigned*)&o1;
#pragma unroll
      for (int e = 0; e < 4; ++e) {
        o[2 * e] = bf2f((bf16_t)(a0[e] & 0xffff)) + bf2f((bf16_t)(a1[e] & 0xffff));
        o[2 * e + 1] = bf2f((bf16_t)(a0[e] >> 16)) + bf2f((bf16_t)(a1[e] >> 16));
      }
      float ss = 0.f;
#pragma unroll
      for (int e = 0; e < 8; ++e) ss += o[e] * o[e];
      ss += __shfl_xor(ss, 1); ss += __shfl_xor(ss, 2); ss += __shfl_xor(ss, 4); ss += __shfl_xor(ss, 8);
      const float rinv = rsqrtf(ss * (1.0f / 128.0f) + EPS);
      const float* nw = p.gdn_norm + li * 128 + sub * 8;
      const unsigned* zz = (const unsigned*)&zv;
      float y[8];
#pragma unroll
      for (int e = 0; e < 4; ++e) {
        y[2 * e] = o[2 * e] * rinv * nw[2 * e] * silu_fast(bf2f((bf16_t)(zz[e] & 0xffff)));
        y[2 * e + 1] = o[2 * e + 1] * rinv * nw[2 * e + 1] * silu_fast(bf2f((bf16_t)(zz[e] >> 16)));
      }
      const uint2 lo = pack4(y[0], y[1], y[2], y[3]), hi = pack4(y[4], y[5], y[6], y[7]);
      *(uint4*)(((bf16_t*)(p.ws + WsOff::mixh)) + gt * 1024 + h * 128 + sub * 8) = make_uint4(lo.x, lo.y, hi.x, hi.y);
    }
  }
}
__device__ __forceinline__ void h0_vec(const float* src, const float* modrow, bf16_t* dst, int j) {
  const float4 x0 = *(const float4*)src, x1 = *(const float4*)(src + 4);
  const float4 h0 = *(const float4*)(modrow + j), h1 = *(const float4*)(modrow + j + 4);
  const float4 c0 = *(const float4*)(modrow + 1024 + j), c1 = *(const float4*)(modrow + 1024 + j + 4);
  const uint2 lo = pack4(x0.x * (1.0f + c0.x) + h0.x, x0.y * (1.0f + c0.y) + h0.y, x0.z * (1.0f + c0.z) + h0.z, x0.w * (1.0f + c0.w) + h0.w);
  const uint2 hi = pack4(x1.x * (1.0f + c1.x) + h1.x, x1.y * (1.0f + c1.y) + h1.y, x1.z * (1.0f + c1.z) + h1.z, x1.w * (1.0f + c1.w) + h1.w);
  *(uint4*)dst = make_uint4(lo.x, lo.y, hi.x, hi.y);
}
#define FOR_ITEMS(n) for (long i = (long)blockIdx.x * 256 + opaque_tid(wv), gstride_ = (long)gridDim.x * 256; i < (long)(n); i += gstride_)
#ifndef REP_ATTIN
#define REP_ATTIN 1
#endif
#ifndef REP_UP
#define REP_UP 1
#endif
#ifndef REP_ATT
#define REP_ATT 1
#endif
#ifndef REP_RECIN
#define REP_RECIN 1
#endif
#ifndef REP_CHUNK
#define REP_CHUNK 1
#endif
#ifndef REP_SCAN
#define REP_SCAN 1
#endif
#ifndef REP_MIX
#define REP_MIX 1
#endif
#ifndef REP_SYNC
#define REP_SYNC 1
#endif
#ifndef SCAN_MODE
#define SCAN_MODE 0
#endif
#define GSYNC() for (int rs_ = 0; rs_ < REP_SYNC; ++rs_) xcd_barrier(((unsigned*)(p.ws + WsOff::bar)), opaque_tid(wv))
__device__ __forceinline__ int convert_inproj(const Params& p, int layer, int u0, char* smem, int tid) {
  const int li2 = layer >> 1;
  const bool att = (layer & 1) == 0;
  const float* src = att ? p.att_w_in + (size_t)li2 * D * ATT_IN : p.rec_w_in + (size_t)li2 * D * REC_IN;
  return wconv_matrix(src, att ? ATT_IN : REC_IN, att ? ATT_NPAD : REC_NPAD, D, ((bf16_t*)(p.ws + WsOff::WtIn)), att ? 1 : 4, nullptr, u0, smem, tid);
}

__global__ void __launch_bounds__(256, 2) megakernel(Params p) {
  cg::grid_group grid = cg::this_grid();
  const int wv = wave_index();
  __shared__ __attribute__((aligned(16))) char smem[LDS_BYTES];
  if (opaque_tid(wv) == 0) { *(volatile unsigned*)(smem + XB_LDS_OFF) = 0u; *(volatile unsigned*)(smem + XB_LDS_OFF + 4) = 0u; }
  __syncthreads();
  xcd_barrier_post(((unsigned*)(p.ws + WsOff::bar)), opaque_tid(wv));
#ifndef REP_PRO
#define REP_PRO 1
#endif
  for (int rpp = 0; rpp < REP_PRO; ++rpp) {
  mod_phase(p, smem, opaque_tid(wv));
  {
    const int tid = opaque_tid(wv);
    int u0 = convert_inproj(p, 0, 0, smem, tid);
    for (int li3 = 0; li3 < 2; ++li3) {
      u0 = wconv_matrix(p.mla_w_uq + (size_t)li3 * 256 * 768, 768, 768, 256, ((bf16_t*)(p.ws + WsOff::Wuq)) + (size_t)li3 * 768 * 256, 2,
                        p.mla_q_norm + li3 * 256, u0, smem, tid);
      u0 = wconv_matrix(p.mla_w_ukv + (size_t)li3 * 128 * 1024, 1024, 1024, 128, ((bf16_t*)(p.ws + WsOff::Wukv)) + (size_t)li3 * 1024 * 128, 3,
                        p.mla_kv_norm + li3 * 128, u0, smem, tid);
    }
    for (int mat = blockIdx.x; mat < 64; mat += gridDim.x)
      wconv_tile(p.lru_gate_w + (size_t)mat * 4096, 64, 64, ((bf16_t*)(p.ws + WsOff::WG)) + (size_t)mat * 4096, 0, nullptr, 0, 0, smem, tid);
  }
  FOR_ITEMS(64 * 16 + 64 * 8) { rope_table_item(p, (int)i); }
  }
  GSYNC();
  FOR_ITEMS((long)NB * SEQ * (D / 8)) {
    const int j = (int)(i & 127) * 8; const long row = i >> 7; const int b = (int)(row / SEQ); const int t = (int)(row - (long)b * SEQ);
    h0_vec(p.x + row * D + j, ((float*)(p.ws + WsOff::modv)) + (size_t)b * 3072, ((bf16_t*)(p.ws + WsOff::H)) + ((size_t)b * NT + t) * D + j, j);
  }
  FOR_ITEMS((long)NB * CTX * (D / 8)) {
    const int j = (int)(i & 127) * 8; const long row = i >> 7; const int b = (int)(row / CTX); const int t = (int)(row - (long)b * CTX);
    h0_vec(p.ctx + row * D + j, ((float*)(p.ws + WsOff::modv)) + (size_t)NB * 3072, ((bf16_t*)(p.ws + WsOff::H)) + ((size_t)b * NT + SEQ + t) * D + j, j);
  }
  GSYNC();
  for (int layer = 0; layer < 4; ++layer) {
    const int li = layer >> 1;
    if ((layer & 1) == 0) {
      for (int rp = 0; rp < REP_ATTIN; ++rp) att_inproj_phase(p, layer, smem, wv);
      GSYNC();
      for (int rp = 0; rp < REP_UP; ++rp) upproj_phase(p, layer, smem, wv);
      GSYNC();
      for (int rp = 0; rp < REP_ATT; ++rp) attention_phase<0>(p, smem, wv);
#ifdef ATT_ABL
      attention_phase<ATT_ABL>(p, smem, wv);
#endif
      GSYNC();
    } else {
      for (int rp = 0; rp < REP_RECIN; ++rp) rec_inproj_phase(p, smem, wv);
      GSYNC();
      for (int rp = 0; rp < REP_CHUNK; ++rp) rec_chunk_phase<0>(p, li, smem, wv);
#ifdef CHUNK_SEL
      rec_chunk_phase<CHUNK_SEL>(p, li, smem, wv);
#endif
      GSYNC();
      for (int rp = 0; rp < REP_SCAN; ++rp) { rec_scan_phase(p, li, li + 2 * rp, rp == 0 ? 0 : SCAN_MODE, smem, wv); __syncthreads(); if (rp + 1 < REP_SCAN) GSYNC(); }
      if (layer == 1) grid.sync(); else GSYNC();
      for (int rp = 0; rp < REP_MIX; ++rp) rec_mix_phase(p, li, smem, wv);
      GSYNC();
    }
    outproj_phase<false>(p, layer, smem, wv);
#ifdef OUT_EXTRA
    outproj_phase<true>(p, layer, smem, wv);
#endif
    GSYNC();
#ifdef LN_EXTRA
    ln_phase<true>(p, layer, wv);
#endif
    ln_phase<false>(p, layer, wv);
    if (layer < 3) (void)convert_inproj(p, layer + 1, 0, smem, opaque_tid(wv));
    GSYNC();
  }
}

extern "C" void kernel_launch(void* const* d_in, const int* in_sizes, int n_in, void* d_out, int out_size,
                              void* d_ws, size_t ws_size, hipStream_t stream) {
  Params p{};
  const float** pp = (const float**)&p;
  for (int i = 0; i < 27; ++i) pp[i] = (const float*)d_in[i];
  p.out = (float*)d_out;
  p.ws = (char*)d_ws;
  const size_t need = WsOff::total;
  if (need > ws_size) { fprintf(stderr, "workspace too small: need %zu have %zu\n", need, ws_size); return; }
  static int grid_blocks = 0;
  if (!grid_blocks) {
    int dev = 0, cus = 0, per_cu = 0;
    (void)hipGetDevice(&dev);
    (void)hipDeviceGetAttribute(&cus, hipDeviceAttributeMultiprocessorCount, dev);
    (void)hipOccupancyMaxActiveBlocksPerMultiprocessor(&per_cu, megakernel, 256, 0);
    if (per_cu > 2) per_cu = 2;
    grid_blocks = cus * per_cu;
  }
  (void)hipMemsetAsync((char*)d_ws + WsOff::bar, 0, (size_t)XCD_BAR_WORDS * 4, stream);
  void* args[] = {&p};
  hipError_t e = hipLaunchCooperativeKernel((void*)megakernel, dim3(grid_blocks), dim3(256), args, 0, stream);
  if (e != hipSuccess) fprintf(stderr, "cooperative launch failed: %s (grid %d)\n", hipGetErrorString(e), grid_blocks);
}
#endif
```
